# Optimizing an MI355X kernel written in HIP

```python
import jax, jax.numpy as jnp
from jax import lax
import numpy as np

D_MODEL = 1024
BATCH = 16
SEQ = 4096
DEPTH = 2
DEC_BATCH = 1
DEC_SEQ = 16384
PAST_LEN = 128

N_BRANCH = 4
BR_W = D_MODEL // N_BRANCH
N_GROUPS = 4
GROUP_W = BR_W // N_GROUPS
CHUNK = 128
POOL_WINDOWS = (2, 4, 8, 16)
CONV_A_W = 3
CONV_D_W = 31
ALPHA = (2 * DEPTH) ** 0.25
BETA = (8 * DEPTH) ** -0.25
LN_EPS = 1e-5

N_BR_COLS = 12
IN_COLS = N_BR_COLS * BR_W + N_BRANCH * D_MODEL
SPLIT_POINTS = tuple(BR_W * i for i in range(1, N_BR_COLS + 1))

kernel_name = "hybrid_gated_parallel_encoder"


def layer_norm(x, g, b):
    xf = x.astype(jnp.float32)
    mu = jnp.mean(xf, axis=-1, keepdims=True)
    var = jnp.mean(jnp.square(xf - mu), axis=-1, keepdims=True)
    return ((xf - mu) * lax.rsqrt(var + LN_EPS) * g.astype(jnp.float32) + b.astype(jnp.float32)).astype(x.dtype)


def depthwise_conv(x, w, pad):
    c = x.shape[-1]
    return lax.conv_general_dilated(
        x, w[:, None, :].astype(x.dtype), window_strides=(1,), padding=[(pad, pad)],
        dimension_numbers=("NWC", "WIO", "NWC"), feature_group_count=c)


def short_conv_mixer(h, bg, cg, w_conv):
    return bg * depthwise_conv(cg * h, w_conv, CONV_A_W // 2)


def spatial_gating(u, v, g, b, w_s, b_s):
    bn, s, _ = v.shape
    vn = layer_norm(v, g, b).reshape(bn, s // CHUNK, CHUNK, N_GROUPS, GROUP_W)
    mixed = jnp.einsum("hpq,bnqhc->bnphc", w_s.astype(v.dtype), vn) + b_s.T[None, None, :, :, None]
    return u * mixed.reshape(bn, s, BR_W).astype(u.dtype)


def multiscale_pool(p, w_pool, scale):
    bn, s, _ = p.shape
    pos = jnp.arange(s)
    outs = []
    for gi, win in enumerate(POOL_WINDOWS):
        xg = p[..., gi * GROUP_W:(gi + 1) * GROUP_W].astype(jnp.float32)
        half = win // 2
        xp = jnp.pad(xg, ((0, 0), (half, half), (0, 0)))
        cs = jnp.concatenate([jnp.zeros_like(xp[:, :1]), jnp.cumsum(xp, axis=1)], axis=1)
        wsum = cs[:, 2 * half:2 * half + s] - cs[:, :s]
        cnt = (jnp.minimum(pos + half, s) - jnp.maximum(pos - half, 0)).astype(jnp.float32)
        pooled = (wsum / cnt[None, :, None] - xg).astype(p.dtype)
        outs.append(jnp.einsum("bsc,cd->bsd", pooled, w_pool[gi]))
    return jnp.concatenate(outs, axis=-1) * scale


def conformer_conv(a, ag, w_dw, b_dw, g, b, w_pw):
    hh = a * jax.nn.sigmoid(ag)
    hh = depthwise_conv(hh, w_dw, CONV_D_W // 2) + b_dw
    hh = jax.nn.silu(layer_norm(hh, g, b))
    return hh @ w_pw


def encoder_layer(x, w_in, conv_a, ln_v_g, ln_v_b, w_s, b_s, w_pool, pool_scale,
                  conv_d, conv_d_b, ln_d_g, ln_d_b, w_pw_d, w_br, w_out, ln_g, ln_b):
    bn, s, _ = x.shape
    proj = x @ w_in
    (a_h, a_b, a_c, a_z, b_u, b_v, b_z, c_p, c_z, d_a, d_g, d_z, gates) = jnp.split(proj, SPLIT_POINTS, axis=-1)
    y_a = short_conv_mixer(a_h, a_b, a_c, conv_a) * jax.nn.silu(a_z)
    y_b = spatial_gating(b_u, b_v, ln_v_g, ln_v_b, w_s, b_s) * jax.nn.silu(b_z)
    y_c = multiscale_pool(c_p, w_pool, pool_scale) * jax.nn.silu(c_z)
    y_d = conformer_conv(d_a, d_g, conv_d, conv_d_b, ln_d_g, ln_d_b, w_pw_d) * jax.nn.silu(d_z)
    ys = jnp.stack([y_a, y_b, y_c, y_d], axis=2)
    br = jnp.einsum("bsic,icd->bsid", ys, w_br)
    g = jax.nn.sigmoid(gates.reshape(bn, s, N_BRANCH, D_MODEL))
    merged = jnp.sum(g * br, axis=2)
    out = merged @ w_out
    return layer_norm(ALPHA * x + out, ln_g, ln_b)


def run_trunk(x, w_in, conv_a, ln_v_g, ln_v_b, w_s, b_s, w_pool, pool_scale,
              conv_d, conv_d_b, ln_d_g, ln_d_b, w_pw_d, w_br, w_out, ln_g, ln_b):
    for l in range(DEPTH):
        x = encoder_layer(x, w_in[l], conv_a[l], ln_v_g[l], ln_v_b[l], w_s[l], b_s[l], w_pool[l],
                          pool_scale[l], conv_d[l], conv_d_b[l], ln_d_g[l], ln_d_b[l], w_pw_d[l],
                          w_br[l], w_out[l], ln_g[l], ln_b[l])
    return x


def setup_inputs(seed: int = 0) -> dict:
    key = jax.random.key(seed)
    ks = jax.random.split(key, 20)
    n = jax.random.normal
    f32 = jnp.float32
    return {
        "x_prompt": n(ks[0], (BATCH, SEQ, D_MODEL), f32),
        "x_sample": n(ks[1], (DEC_BATCH, DEC_SEQ, D_MODEL), f32),
        "w_in": n(ks[2], (DEPTH, D_MODEL, IN_COLS), f32) * D_MODEL ** -0.5,
        "conv_a": n(ks[3], (DEPTH, CONV_A_W, BR_W), f32) * CONV_A_W ** -0.5,
        "ln_v_g": 1.0 + 0.02 * n(ks[4], (DEPTH, BR_W), f32),
        "ln_v_b": 0.02 * n(ks[5], (DEPTH, BR_W), f32),
        "w_s": n(ks[6], (DEPTH, N_GROUPS, CHUNK, CHUNK), f32) * 0.5 * CHUNK ** -0.5,
        "b_s": 1.0 + 0.02 * n(ks[7], (DEPTH, N_GROUPS, CHUNK), f32),
        "w_pool": n(ks[8], (DEPTH, N_GROUPS, GROUP_W, GROUP_W), f32) * GROUP_W ** -0.5,
        "pool_scale": 1.0 + 0.02 * n(ks[9], (DEPTH, BR_W), f32),
        "conv_d": n(ks[10], (DEPTH, CONV_D_W, BR_W), f32) * CONV_D_W ** -0.5,
        "conv_d_b": 0.02 * n(ks[11], (DEPTH, BR_W), f32),
        "ln_d_g": 1.0 + 0.02 * n(ks[12], (DEPTH, BR_W), f32),
        "ln_d_b": 0.02 * n(ks[13], (DEPTH, BR_W), f32),
        "w_pw_d": n(ks[14], (DEPTH, BR_W, BR_W), f32) * BR_W ** -0.5,
        "w_br": n(ks[15], (DEPTH, N_BRANCH, BR_W, D_MODEL), f32) * (BR_W ** -0.5 * BETA),
        "w_out": n(ks[16], (DEPTH, D_MODEL, D_MODEL), f32) * (D_MODEL ** -0.5 * BETA),
        "ln_g": 1.0 + 0.02 * n(ks[17], (DEPTH, D_MODEL), f32),
        "ln_b": 0.02 * n(ks[18], (DEPTH, D_MODEL), f32),
    }


def reference(x_prompt, x_sample, w_in, conv_a, ln_v_g, ln_v_b, w_s, b_s, w_pool, pool_scale,
              conv_d, conv_d_b, ln_d_g, ln_d_b, w_pw_d, w_br, w_out, ln_g, ln_b):
    y_prompt = run_trunk(x_prompt, w_in, conv_a, ln_v_g, ln_v_b, w_s, b_s, w_pool, pool_scale,
                         conv_d, conv_d_b, ln_d_g, ln_d_b, w_pw_d, w_br, w_out, ln_g, ln_b)
    y_sample = run_trunk(x_sample, w_in, conv_a, ln_v_g, ln_v_b, w_s, b_s, w_pool, pool_scale,
                         conv_d, conv_d_b, ln_d_g, ln_d_b, w_pw_d, w_br, w_out, ln_g, ln_b)
    return (y_prompt, y_sample)
```

```cpp
#include <hip/hip_runtime.h>
#include <hip/hip_cooperative_groups.h>
#include <cstdio>
#include <cstdint>
namespace cg = cooperative_groups;

namespace pg8 {
#define PG8_LAS __attribute__((address_space(3)))
typedef unsigned short bf16_t;
typedef short bf16x8 __attribute__((ext_vector_type(8)));
typedef float f32x4 __attribute__((ext_vector_type(4)));
typedef unsigned u32x4 __attribute__((ext_vector_type(4)));
typedef unsigned u32x2 __attribute__((ext_vector_type(2)));
typedef float f32x2 __attribute__((ext_vector_type(2)));
constexpr int BM = 256, BK = 64, HALF = 128, HTB = HALF * BK * 2, STAGE_BYTES = 8 * HTB, NXCD = 8, WGM = 8;

__host__ __device__ __forceinline__ int lds_byte(int r, int c) { const int st = (r >> 4) * 2 + (c >> 5), rr = r & 15, cc = c & 31, ob = rr * 64 + cc * 2; return st * 1024 + (ob ^ (((ob >> 9) & 1) << 5)); }
__host__ __device__ __forceinline__ void stage_rc(int b, int& R, int& C) { const int st = b / 1024, sb = b % 1024, swz = sb ^ (((sb >> 9) & 1) << 5); R = (st >> 1) * 16 + swz / 64; C = (st & 1) * 32 + (swz % 64) / 2; }
__host__ __device__ __forceinline__ int perm32(int rho) { const int n = rho >> 4, i = rho & 15; return 8 * (i >> 2) + 4 * n + (i & 3); }

struct Unit { int pm, pn, kb; };
struct Gemm { const bf16_t* A; const bf16_t* Bt; };

struct StaticOrder {
    int nM, nN, nwg, G, c;
    __host__ __device__ void init(int M, int N, int G_, int c_) { nM = M / BM; nN = N / BM; nwg = nM * nN; G = G_; c = c_; }
    __host__ __device__ bool next(int i, Unit& u) const {
        const long L = (long)i * G + c; if (L >= nwg) return false;
        u.kb = 0;
        if (((G | nwg | nM) & 7) == 0) {
            const int wgid = (c & 7) * (nwg >> 3) + (c >> 3) + i * (G >> 3), nig = WGM * nN, gid = wgid / nig, rem = wgid - gid * nig;
            u.pm = gid * WGM + (rem & (WGM - 1)); u.pn = rem / WGM; return true;
        }
        int wgid = (int)L; { const int q = nwg / NXCD, r = nwg % NXCD, xcd = wgid % NXCD, off = wgid / NXCD; wgid = (xcd < r ? xcd * (q + 1) : r * (q + 1) + (xcd - r) * q) + off; }
        const int nig = WGM * nN, gid = wgid / nig, fm = gid * WGM, gsz = (nM - fm) < WGM ? (nM - fm) : WGM;
        u.pm = fm + ((wgid % nig) % gsz); u.pn = (wgid % nig) / gsz; return true;
    }
};
template <int NSUB> struct SubOrder {
    StaticOrder S;
    __host__ __device__ bool next(int i, Unit& u) const { if (!S.next(i / NSUB, u)) return false; u.kb = i % NSUB; return true; }
};

template <class Base, int REP> struct RepOrder {
    Base S; int n;
    __host__ __device__ bool next(int i, Unit& u) const { if constexpr (REP == 1) return S.next(i, u); else { if (i >= REP * n) return false; return S.next(i % n, u); } }
};
__device__ __forceinline__ unsigned cvt_pk_bf16(float lo, float hi) { unsigned r; asm volatile("v_cvt_pk_bf16_f32 %0, %1, %2" : "=v"(r) : "v"(lo), "v"(hi)); return r; }
__device__ __forceinline__ float sigm(float x) { return __builtin_amdgcn_rcpf(1.f + __expf(-x)); }
__device__ __forceinline__ float bflo(unsigned w) { return __uint_as_float(w << 16); }
__device__ __forceinline__ float bfhi(unsigned w) { return __uint_as_float(w & 0xffff0000u); }

#define PG8_ZERO_ACC(acc) do { _Pragma("unroll") for (int a_ = 0; a_ < 2; ++a_) _Pragma("unroll") for (int b_ = 0; b_ < 2; ++b_) _Pragma("unroll") for (int m_ = 0; m_ < 4; ++m_) _Pragma("unroll") for (int n_ = 0; n_ < 2; ++n_) acc[a_][b_][m_][n_] = (f32x4){0.f, 0.f, 0.f, 0.f}; } while (0)

template <bool FOLD, bool SIG> struct EpiStoreBf16 {
    static constexpr bool PERM = true;
    bf16_t* O; int ldc;
    const float* stats;
    const float* cs; const float* bw;
    __device__ __forceinline__ void operator()(f32x4 (&acc)[2][2][4][2], const Unit& u, int wr, int wc, int fr, int fq) const {
        const int row0 = u.pm * BM + wr * 64 + fr, col0 = u.pn * BM + wc * 32 + 8 * fq;
        if constexpr (FOLD) {
            float mu[2][4], rs[2][4];
#pragma unroll
            for (int ai = 0; ai < 2; ++ai)
#pragma unroll
                for (int m = 0; m < 4; ++m) { const size_t row = (size_t)(row0 + ai * HALF + m * 16);
                    const float sm = stats[2 * row], sq = stats[2 * row + 1];
                    mu[ai][m] = sm * (1.f / 1024.f); rs[ai][m] = __builtin_amdgcn_rsqf(fmaxf(sq * (1.f / 1024.f) - mu[ai][m] * mu[ai][m], 0.f) + 1e-5f); }
            f32x4 c4[2][2], b4[2][2];
#pragma unroll
            for (int bj = 0; bj < 2; ++bj)
#pragma unroll
                for (int n = 0; n < 2; ++n) { c4[bj][n] = *(const f32x4*)(cs + col0 + bj * HALF + 4 * n); b4[bj][n] = *(const f32x4*)(bw + col0 + bj * HALF + 4 * n); }
#pragma unroll
            for (int bj = 0; bj < 2; ++bj)
#pragma unroll
                for (int n = 0; n < 2; ++n)
#pragma unroll
                    for (int ai = 0; ai < 2; ++ai)
#pragma unroll
                        for (int m = 0; m < 4; ++m) acc[ai][bj][m][n] = (acc[ai][bj][m][n] - c4[bj][n] * mu[ai][m]) * rs[ai][m] + b4[bj][n];
        }
        if constexpr (SIG) {
            char* gt_ = (char*)(O + (size_t)(u.pm * BM) * ldc + u.pn * 64);
            const unsigned gl_ = (unsigned)((wr * 64 + fr) * ldc + wc * 16 + 4 * fq) * 2u;
#pragma unroll
            for (int ai = 0; ai < 2; ++ai)
#pragma unroll
                for (int m = 0; m < 4; ++m) {
                    f32x4 tq[4], sg[4];
#pragma unroll
                    for (int i = 0; i < 4; ++i) { const f32x4 v = acc[ai][i >> 1][m][i & 1];
#pragma unroll
                        for (int e = 0; e < 4; ++e) { tq[i][e] = 1.f + __builtin_amdgcn_exp2f(fmaxf(v[e], -30.f) * -1.4426950408889634f); sg[i][e] = __builtin_amdgcn_rcpf(tq[i][e]); } }
                    char* rowp = gt_ + (size_t)((ai * HALF + m * 16) * ldc) * 2;
#pragma unroll
                    for (int i = 0; i < 4; ++i) { const f32x4 r = i < 3 ? sg[i] * tq[i < 3 ? i + 1 : 3] : sg[3];
                        u32x2 w; w.x = cvt_pk_bf16(r[0], r[1]); w.y = cvt_pk_bf16(r[2], r[3]);
                        *(u32x2*)(rowp + i * 2048 + gl_) = w; }
                }
        } else {
        char* tile = (char*)(O + (size_t)(u.pm * BM) * ldc + u.pn * BM);
        const unsigned lofs = (unsigned)((wr * 64 + fr) * ldc + wc * 32 + 8 * fq) * 2u;
#pragma unroll
        for (int ai = 0; ai < 2; ++ai)
#pragma unroll
            for (int m = 0; m < 4; ++m) { char* rowp = tile + (size_t)((ai * HALF + m * 16) * ldc) * 2;
#pragma unroll
                for (int bj = 0; bj < 2; ++bj) { const f32x4 v0 = acc[ai][bj][m][0], v1 = acc[ai][bj][m][1];
                    u32x4 w; w.x = cvt_pk_bf16(v0[0], v0[1]); w.y = cvt_pk_bf16(v0[2], v0[3]); w.z = cvt_pk_bf16(v1[0], v1[1]); w.w = cvt_pk_bf16(v1[2], v1[3]);
                    *(u32x4*)(rowp + bj * HALF * 2 + lofs) = w; } }
        }
        PG8_ZERO_ACC(acc);
    }
};

struct EpiGate {
    static constexpr bool PERM = true;
    const bf16_t* Gt; int ldg;
    bf16_t* O; int ldc;
    __device__ __forceinline__ void operator()(f32x4 (&acc)[2][2][4][2], const Unit& u, int wr, int wc, int fr, int fq) const {
        const bool last = u.kb == 3;
        const char* gtile = (const char*)(Gt + (size_t)(u.pm * BM) * ldg + u.kb * 1024 + u.pn * BM);
        char* otile = (char*)(O + (size_t)(u.pm * BM) * ldc + u.pn * BM);
        int frl = fr; asm volatile("" : "+v"(frl));
        const unsigned glofs = (unsigned)((wr * 64 + frl) * ldg + wc * 32 + 8 * fq) * 2u, olofs = (unsigned)((wr * 64 + frl) * ldc + wc * 32 + 8 * fq) * 2u;
        const float keep = last ? 0.f : 1.f;
#pragma unroll
        for (int ai = 0; ai < 2; ++ai) {
            u32x4 ga[4][2];
#pragma unroll
            for (int m = 0; m < 4; ++m)
#pragma unroll
                for (int bj = 0; bj < 2; ++bj) ga[m][bj] = *(const u32x4*)(gtile + (size_t)((ai * HALF + m * 16) * ldg + bj * HALF) * 2 + glofs);
#pragma unroll
            for (int m = 0; m < 4; ++m)
#pragma unroll
                for (int bj = 0; bj < 2; ++bj) {
                    const u32x4 va = ga[m][bj];
                    f32x4 v0 = acc[ai][bj][m][0], v1 = acc[ai][bj][m][1];
                    v0[0] *= bflo(va.x); v0[1] *= bfhi(va.x); v0[2] *= bflo(va.y); v0[3] *= bfhi(va.y); v1[0] *= bflo(va.z); v1[1] *= bfhi(va.z); v1[2] *= bflo(va.w); v1[3] *= bfhi(va.w);
                    if (last) {
                        u32x4 w; w.x = cvt_pk_bf16(v0[0], v0[1]); w.y = cvt_pk_bf16(v0[2], v0[3]); w.z = cvt_pk_bf16(v1[0], v1[1]); w.w = cvt_pk_bf16(v1[2], v1[3]);
                        *(u32x4*)(otile + (size_t)((ai * HALF + m * 16) * ldc + bj * HALF) * 2 + olofs) = w;
                    }
                    acc[ai][bj][m][0] = v0 * keep; acc[ai][bj][m][1] = v1 * keep;
                }
            asm volatile("" ::: "memory");
        }
    }
};

template <bool L1> struct EpiRes {
    static constexpr bool PERM = false;
    const float* base; const float* bstats; const float* lg; const float* lb;
    float* O; bf16_t* XO; float* ostats; int ldc; float alpha;
    __device__ __forceinline__ void operator()(f32x4 (&acc)[2][2][4][2], const Unit& u, int wr, int wc, int fr, int fq) const {
        const int row0 = u.pm * BM + wr * 64 + fr, col0 = u.pn * BM + wc * 32 + 4 * fq;
        const char* btile = (const char*)(base + (size_t)(u.pm * BM) * ldc + u.pn * BM); char* otile = (char*)(O + (size_t)(u.pm * BM) * ldc + u.pn * BM);
        char* xtile = (char*)(XO + (size_t)(u.pm * BM) * ldc + u.pn * BM);
        const unsigned lofs = (unsigned)((wr * 64 + fr) * ldc + wc * 32 + 4 * fq) * 4u;
        f32x4 g4[2][2], b4[2][2];
        if constexpr (L1) {
#pragma unroll
            for (int bj = 0; bj < 2; ++bj)
#pragma unroll
                for (int n = 0; n < 2; ++n) { g4[bj][n] = *(const f32x4*)(lg + col0 + bj * HALF + n * 16); b4[bj][n] = *(const f32x4*)(lb + col0 + bj * HALF + n * 16); }
        }
        constexpr int NB = L1 ? 2 : 4;
#pragma unroll
        for (int aim = 0; aim < 8 / NB; ++aim) { const int ai = (aim * NB) >> 2, mh = (aim * NB) & 3;
            f32x4 xv[NB][2][2];
#pragma unroll
            for (int mm = 0; mm < NB; ++mm)
#pragma unroll
                for (int bj = 0; bj < 2; ++bj)
#pragma unroll
                    for (int n = 0; n < 2; ++n) xv[mm][bj][n] = *(const f32x4*)(btile + (size_t)((ai * HALF + (mh + mm) * 16) * ldc + bj * HALF + n * 16) * 4 + lofs);
            float mu2[NB], rs2[NB];
#pragma unroll
            for (int mm = 0; mm < NB; ++mm) { mu2[mm] = 0.f; rs2[mm] = 1.f; }
            if constexpr (L1) {
                f32x2 st2[NB];
#pragma unroll
                for (int mm = 0; mm < NB; ++mm) st2[mm] = *(const f32x2*)(bstats + 2 * (size_t)(row0 + ai * HALF + (mh + mm) * 16));
#pragma unroll
                for (int mm = 0; mm < NB; ++mm) { mu2[mm] = st2[mm][0] * (1.f / 1024.f); rs2[mm] = __builtin_amdgcn_rsqf(fmaxf(st2[mm][1] * (1.f / 1024.f) - mu2[mm] * mu2[mm], 0.f) + 1e-5f); }
            }
#pragma unroll
            for (int mm = 0; mm < NB; ++mm) { const int m = mh + mm; const size_t row = (size_t)(row0 + ai * HALF + m * 16); const size_t uo = (size_t)((ai * HALF + m * 16) * ldc);
                f32x4 ps4 = (f32x4){0.f, 0.f, 0.f, 0.f}, pq4 = ps4;
#pragma unroll
                for (int bj = 0; bj < 2; ++bj)
#pragma unroll
                    for (int n = 0; n < 2; ++n) { f32x4 x = xv[mm][bj][n];
                        if constexpr (L1) x = (x - mu2[mm]) * rs2[mm] * g4[bj][n] + b4[bj][n];
                        const f32x4 v = x * alpha + acc[ai][bj][m][n];
                        *(f32x4*)(otile + (uo + bj * HALF + n * 16) * 4 + lofs) = v;
                        if constexpr (!L1) { u32x2 w; w.x = cvt_pk_bf16(v[0], v[1]); w.y = cvt_pk_bf16(v[2], v[3]); *(u32x2*)(xtile + (uo + bj * HALF + n * 16) * 2 + (lofs >> 1)) = w; }
                        ps4 += v; pq4 += v * v; }
                float ps = (ps4[0] + ps4[1]) + (ps4[2] + ps4[3]), pq = (pq4[0] + pq4[1]) + (pq4[2] + pq4[3]);
                ps += __shfl_xor(ps, 16); ps += __shfl_xor(ps, 32); pq += __shfl_xor(pq, 16); pq += __shfl_xor(pq, 32);
                if (fq == 0) { atomicAdd(ostats + 2 * row, ps); atomicAdd(ostats + 2 * row + 1, pq); } }
            asm volatile("" ::: "memory");
        }
        PG8_ZERO_ACC(acc);
    }
};

template <class Epi, class Sched, bool ALIGN_EPI, int KU>
__device__ __forceinline__ void gemm_phase(PG8_LAS unsigned char* lds, const Gemm g, const Sched& S, const Epi& E, const int tid) {
    const int wid = __builtin_amdgcn_readfirstlane(tid >> 6), lane = tid & 63, wr = wid >> 2, wc = wid & 3, fr = lane & 15, fq = lane >> 4;
    constexpr int K = KU, nt = K / BK, LD = 1024;
    unsigned voffA[2], voffB[2];
#pragma unroll
    for (int i = 0; i < 2; ++i) { int R, C; stage_rc(tid * 16 + i * 8192, R, C); const int Rb = Epi::PERM ? ((R & ~31) + perm32(R & 31)) : R;
        voffA[i] = (unsigned)(R * LD + C) * 2u; voffB[i] = (unsigned)(Rb * LD + C) * 2u; }
    constexpr size_t kstep = (size_t)(BK * 2);
    constexpr size_t hstepA = (size_t)HALF * LD * 2, hstepB = hstepA;
    constexpr size_t tstepA = 2 * hstepA, tstepB = 2 * hstepB;
    constexpr size_t ksub = (size_t)K * 2;
    const unsigned ldsw = (unsigned)wid * 1024u;
    const int aoff = lds_byte(wr * 64 + fr, fq * 8), boff = lds_byte(wc * 32 + fr, fq * 8);
#define PG8_SA(b, h) (((b) * 2 + (h)) * HTB)
#define PG8_SB(b, h) ((4 + (b) * 2 + (h)) * HTB)
#define PG8_STAGE(bufoff, gbase, voff) do { _Pragma("unroll") for (int _i = 0; _i < 2; ++_i) \
        __builtin_amdgcn_global_load_lds((const unsigned*)((const char*)(gbase) + (voff)[_i]), (PG8_LAS unsigned*)(lds + (bufoff) + ldsw + _i * 8192), 16, 0, 0); } while (0)
#define PG8_LDA(dst, b, h) do { _Pragma("unroll") for (int m = 0; m < 4; ++m) _Pragma("unroll") for (int k = 0; k < 2; ++k) dst[m][k] = *(const PG8_LAS bf16x8*)(lds + PG8_SA(b, h) + aoff + m * 2048 + k * 1024); } while (0)
#define PG8_LDB(dst, b, h) do { _Pragma("unroll") for (int n = 0; n < 2; ++n) _Pragma("unroll") for (int k = 0; k < 2; ++k) dst[n][k] = *(const PG8_LAS bf16x8*)(lds + PG8_SB(b, h) + boff + n * 2048 + k * 1024); } while (0)
#define PG8_MMA(ai, bj, At, Bt) do { __builtin_amdgcn_s_setprio(1); _Pragma("unroll") for (int m = 0; m < 4; ++m) _Pragma("unroll") for (int n = 0; n < 2; ++n) _Pragma("unroll") for (int k = 0; k < 2; ++k) \
        acc[ai][bj][m][n] = __builtin_amdgcn_mfma_f32_16x16x32_bf16(Bt[n][k], At[m][k], acc[ai][bj][m][n], 0, 0, 0); __builtin_amdgcn_s_setprio(0); } while (0)
#define PG8_WAIT_V(n) asm volatile("s_waitcnt vmcnt(" #n ")" ::: "memory")
#define PG8_WAIT_L(n) asm volatile("s_waitcnt lgkmcnt(" #n ")" ::: "memory")
#define PG8_BAR __builtin_amdgcn_s_barrier()
#define PG8_SCHED __builtin_amdgcn_sched_barrier(0)
    Unit cur, nxt; int ui = 0;
    if (!S.next(0, cur)) return;
    f32x4 acc[2][2][4][2];
    PG8_ZERO_ACC(acc);
    bf16x8 At[4][2], B0[2][2], B1[2][2];
    const char* cA = (const char*)g.A + (size_t)cur.pm * tstepA + (size_t)cur.kb * ksub; const char* cB = (const char*)g.Bt + (size_t)cur.pn * tstepB + (size_t)cur.kb * ksub;
    PG8_STAGE(PG8_SB(0, 0), cB, voffB); PG8_STAGE(PG8_SB(0, 1), cB + hstepB, voffB); PG8_STAGE(PG8_SA(0, 0), cA, voffA); PG8_STAGE(PG8_SA(0, 1), cA + hstepA, voffA);
    if (wr == 1) PG8_BAR;
    PG8_WAIT_V(2); PG8_BAR;
    PG8_STAGE(PG8_SB(1, 0), cB + kstep, voffB); PG8_STAGE(PG8_SA(1, 0), cA + kstep, voffA); PG8_STAGE(PG8_SB(1, 1), cB + hstepB + kstep, voffB);
    PG8_WAIT_V(6); PG8_BAR;
    for (;;) {
        const bool has_next = S.next(ui + 1, nxt);
        const char* nA = has_next ? (const char*)g.A + (size_t)nxt.pm * tstepA + (size_t)nxt.kb * ksub : cA;
        const char* nB = has_next ? (const char*)g.Bt + (size_t)nxt.pn * tstepB + (size_t)nxt.kb * ksub : cB;
        for (int t = 0; t < nt; t += 2) {
            const bool last = (t == nt - 2);
            const char* a1 = cA + (size_t)(t + 1) * kstep;
            const char* a2 = last ? nA : cA + (size_t)(t + 2) * kstep; const char* b2 = last ? nB : cB + (size_t)(t + 2) * kstep;
            const char* a3 = a2 + kstep; const char* b3 = b2 + kstep;
            PG8_LDB(B0, 0, 0); PG8_LDB(B1, 0, 1); PG8_SCHED; PG8_LDA(At, 0, 0); PG8_STAGE(PG8_SA(1, 1), a1 + hstepA, voffA);
            PG8_WAIT_V(8); PG8_WAIT_L(0); PG8_BAR; PG8_MMA(0, 0, At, B0); PG8_MMA(0, 1, At, B1); PG8_BAR; PG8_SCHED;
            PG8_LDA(At, 0, 1); PG8_STAGE(PG8_SB(0, 0), b2, voffB); PG8_STAGE(PG8_SB(0, 1), b2 + hstepB, voffB); PG8_STAGE(PG8_SA(0, 0), a2, voffA);
            PG8_WAIT_V(8); PG8_WAIT_L(0); PG8_BAR; PG8_MMA(1, 0, At, B0); PG8_MMA(1, 1, At, B1); PG8_BAR; PG8_SCHED;
            PG8_LDB(B0, 1, 0); PG8_LDB(B1, 1, 1); PG8_SCHED; PG8_LDA(At, 1, 0); PG8_STAGE(PG8_SA(0, 1), a2 + hstepA, voffA);
            PG8_WAIT_V(8); PG8_WAIT_L(0); PG8_BAR; PG8_MMA(0, 0, At, B0); PG8_MMA(0, 1, At, B1); PG8_BAR; PG8_SCHED;
            PG8_LDA(At, 1, 1); PG8_STAGE(PG8_SB(1, 0), b3, voffB); PG8_STAGE(PG8_SB(1, 1), b3 + hstepB, voffB); PG8_STAGE(PG8_SA(1, 0), a3, voffA);
            PG8_WAIT_V(8); PG8_WAIT_L(0); PG8_BAR; PG8_MMA(1, 0, At, B0); PG8_MMA(1, 1, At, B1); PG8_BAR; PG8_SCHED;
        }
        if constexpr (ALIGN_EPI) { if (wr == 0) PG8_BAR; }
        E(acc, cur, wr, wc, fr, fq);
        if (!has_next) break;
        cur = nxt; cA = nA; cB = nB; ++ui;
        if constexpr (ALIGN_EPI) { if (wr == 1) PG8_BAR; }
    }
    PG8_WAIT_V(0);
    if constexpr (!ALIGN_EPI) { if (wr == 0) PG8_BAR; }
    PG8_BAR;
#undef PG8_SA
#undef PG8_SB
#undef PG8_STAGE
#undef PG8_LDA
#undef PG8_LDB
#undef PG8_MMA
#undef PG8_WAIT_V
#undef PG8_WAIT_L
#undef PG8_BAR
#undef PG8_SCHED
}
}

#ifndef REP_G1
#define REP_G1 1
#endif
#ifndef REP_MIX
#define REP_MIX 1
#endif
#ifndef REP_BR
#define REP_BR 1
#endif
#ifndef REP_OUT
#define REP_OUT 1
#endif
#ifndef REP_BAR
#define REP_BAR 1
#endif
#ifndef REP_LN
#define REP_LN 1
#endif
using pg8::bf16_t; using pg8::bf16x8; using pg8::f32x4; using pg8::u32x4; using pg8::u32x2; using pg8::f32x2;
#define LAS __attribute__((address_space(3)))
constexpr int NWAVES = 8, NTHR = 512;
#ifndef TS_ROWS
#define TS_ROWS 16384
#endif
constexpr int D = 1024, NC = 7168, NBRC = 3072, TS = TS_ROWS, TALL = 81920, NSB = TALL / TS, NPROMPT = 65536, DEPTH = 2;
constexpr float LN_EPS = 1e-5f, ALPHA = 1.41421356237309515f;
constexpr size_t MiB = 1u << 20;
constexpr size_t WS_WIN = 1 * MiB, WS_WBR = 29 * MiB, WS_WOUT = 33 * MiB, WS_WPW = 37 * MiB, WS_WPOOL = 38 * MiB, WS_WS = 39 * MiB;
constexpr size_t WS_CSBW = 65536, WS_STATS = 40 * MiB, STATS_BYTES = 2 * MiB;
constexpr size_t WS_XB = 42 * MiB, WS_XB1 = 202 * MiB, WS_PROJ = WS_XB1 + (size_t)TS * D * 2, WS_YS = WS_PROJ + (size_t)TS * NC * 2, WS_MRG = WS_YS + (size_t)TS * D * 2,
                 WS_PRE = WS_MRG + (size_t)TS * D * 2, WS_END = WS_PRE + (size_t)TS * D * 4;
constexpr int LDS_BYTES = 161792 + 64;
constexpr int XB_LDS_OFF = 161792;
constexpr size_t CTL_ZERO_BYTES = 131072;
constexpr int R1_OFF = 96256, VN_OFF = 34816, AROW = 264, VROW = 272;

__device__ __forceinline__ float wave_sum(float v) {
#pragma unroll
    for (int o = 1; o < 64; o <<= 1) v += __shfl_xor(v, o);
    return v;
}
__device__ __forceinline__ float red16(float v) {
    v += __shfl_xor(v, 1); v += __shfl_xor(v, 2); v += __shfl_xor(v, 4); v += __shfl_xor(v, 8); return v;
}
__device__ __forceinline__ unsigned f2bf(float f) { unsigned u = __builtin_bit_cast(unsigned, f); return (u + 0x7fffu + ((u >> 16) & 1u)) >> 16; }
__device__ __forceinline__ unsigned pk2(float lo, float hi) { return f2bf(lo) | (f2bf(hi) << 16); }
__device__ __forceinline__ float sigm(float x) { return __builtin_amdgcn_rcpf(1.f + __expf(-x)); }
__device__ __forceinline__ float silu(float x) { return x * sigm(x); }
__device__ __forceinline__ float bflo(unsigned w) { return __uint_as_float(w << 16); }
__device__ __forceinline__ float bfhi(unsigned w) { return __uint_as_float(w & 0xffff0000u); }
#define UNPACK8(v, f) float f[8] = {bflo((v).x), bfhi((v).x), bflo((v).y), bfhi((v).y), bflo((v).z), bfhi((v).z), bflo((v).w), bfhi((v).w)}
#define MFMA16(x, y, c) __builtin_amdgcn_mfma_f32_16x16x32_bf16((x), (y), (c), 0, 0, 0)

__device__ __forceinline__ int gate_src_col(int nout) {
    const int c = nout - 3072, t = c >> 8, r = c & 255, bj = r >> 7, wc = (r >> 5) & 3, fq = (r >> 3) & 3, n = (r >> 2) & 1, e = r & 3;
    return 3072 + (2 * bj + n) * 1024 + 64 * t + 16 * wc + 4 * fq + e;
}
__device__ __forceinline__ void transpose_item(const float* W, int K, int N, bf16_t* WT, LAS float* scr, int item, int lane, const float* gs, const float* bs, float* cs, float* bw, bool gperm) {
    const int nblk = N / 32, kb = item / nblk, nb = item % nblk, k0 = 64 * kb, n0 = 32 * nb;
    const int scol = (gperm && n0 >= 3072) ? gate_src_col(n0 + (lane & 31)) : n0 + (lane & 31);
#pragma unroll 8
    for (int i = 0; i < 32; ++i) { const int kk = 2 * i + (lane >> 5); scr[kk * 33 + (lane & 31)] = W[(size_t)(k0 + kk) * N + scol]; }
    asm volatile("s_waitcnt lgkmcnt(0)" ::: "memory");
    const int c = lane & 7;
    float gsc[8] = {1.f, 1.f, 1.f, 1.f, 1.f, 1.f, 1.f, 1.f};
    if (gs) {
        float ca = 0.f, ba = 0.f; const int kh = (lane >> 5) * 32, nn = lane & 31;
#pragma unroll 8
        for (int kk = 0; kk < 32; ++kk) { const float w = scr[(kh + kk) * 33 + nn]; ca += __uint_as_float(f2bf(w * gs[k0 + kh + kk]) << 16); ba += w * bs[k0 + kh + kk]; }
        atomicAdd(cs + n0 + nn, ca); atomicAdd(bw + n0 + nn, ba);
#pragma unroll
        for (int j = 0; j < 8; ++j) gsc[j] = gs[k0 + 8 * c + j];
    }
#pragma unroll
    for (int j = 0; j < 4; ++j) { const int n = (lane >> 3) + 8 * j; const LAS float* sp = scr + (8 * c) * 33 + n;
        u32x4 o; o.x = pk2(sp[0 * 33] * gsc[0], sp[1 * 33] * gsc[1]); o.y = pk2(sp[2 * 33] * gsc[2], sp[3 * 33] * gsc[3]); o.z = pk2(sp[4 * 33] * gsc[4], sp[5 * 33] * gsc[5]); o.w = pk2(sp[6 * 33] * gsc[6], sp[7 * 33] * gsc[7]);
        *(u32x4*)(WT + (size_t)(n0 + n) * K + k0 + 8 * c) = o; }
    asm volatile("s_waitcnt lgkmcnt(0)" ::: "memory");
}

#define XB_TMO      128
#define XB_XCNT(j)  (256  + 64 * (j))
#define XB_XSUB(j)  (1280 + 64 * (j))
#define XB_XGEN(j)  (2304 + 64 * (j))
#define XB_TOP      3328
#define XB_TOPGEN   3392
#define XCD_BAR_WORDS 3456
#define XB_SPIN_CAP (1u << 22)
__device__ __forceinline__ unsigned xb_ld(unsigned* p)              { return __hip_atomic_load(p, __ATOMIC_RELAXED, __HIP_MEMORY_SCOPE_AGENT); }
__device__ __forceinline__ unsigned xb_add(unsigned* p, unsigned v) { return __hip_atomic_fetch_add(p, v, __ATOMIC_RELAXED, __HIP_MEMORY_SCOPE_AGENT); }
__device__ __forceinline__ unsigned xb_xcc_id() { return (unsigned)__builtin_amdgcn_s_getreg((3 << 11) | 20) & 0xFu; }
#define XB_SPIN(cond, bar) do { unsigned _sp = 0; while (cond) { __builtin_amdgcn_s_sleep(1); \
    if ((++_sp & 255u) == 0u) { if (xb_ld(&(bar)[XB_TMO])) break; if (_sp > XB_SPIN_CAP) { atomicAdd(&(bar)[XB_TMO], 1u); break; } } } } while (0)
struct XcdBarrier { unsigned* bar; unsigned x; volatile LAS unsigned* st; };
__device__ __forceinline__ XcdBarrier xcd_barrier_post(unsigned* bar, volatile LAS unsigned* st) {
    XcdBarrier b; b.bar = bar; b.x = xb_xcc_id(); b.st = st;
    if (threadIdx.x == 0) (void)xb_add(&bar[XB_XCNT(b.x)], 1u);
    return b;
}
__device__ __forceinline__ void xcd_barrier_complete(unsigned* bar, unsigned x, unsigned& nloc, unsigned& nx) {
    const unsigned G = gridDim.x * gridDim.y * gridDim.z;
    unsigned sum, cnt, mine, sp = 0u;
    for (;;) {
        sum = 0u; cnt = 0u; mine = 0u;
#pragma unroll
        for (unsigned j = 0; j < 16; ++j) { const unsigned c = xb_ld(&bar[XB_XCNT(j)]); sum += c; cnt += (c > 0u) ? 1u : 0u; mine = (j == x) ? c : mine; }
        if (sum == G) break;
        __builtin_amdgcn_s_sleep(1);
        if ((++sp & 255u) == 0u) { if (xb_ld(&bar[XB_TMO])) break; if (sp > XB_SPIN_CAP) { atomicAdd(&bar[XB_TMO], 1u); break; } }
    }
    nloc = mine > 0u ? mine : 1u; nx = cnt > 0u ? cnt : 1u;
}
__device__ __forceinline__ void xcd_barrier(const XcdBarrier& b) {
    asm volatile("s_waitcnt vmcnt(0)" ::: "memory");
    __syncthreads();
    if (threadIdx.x == 0) {
        unsigned* bar = b.bar;
        __builtin_amdgcn_s_waitcnt(0);
        unsigned nloc = b.st[0], nx = b.st[1];
        if (nloc == 0u) { xcd_barrier_complete(bar, b.x, nloc, nx); b.st[0] = nloc; b.st[1] = nx; }
        const unsigned old = xb_add(&bar[XB_XSUB(b.x)], 1u);
        const unsigned gen = old / nloc;
        if (old + 1u == (gen + 1u) * nloc) {
            __builtin_amdgcn_fence(__ATOMIC_RELEASE, "agent");
            asm volatile("s_waitcnt vmcnt(0)" ::: "memory");
            const unsigned og = xb_add(&bar[XB_TOP], 1u);
            const unsigned tg = og / nx;
            if (og + 1u == (tg + 1u) * nx) xb_add(&bar[XB_TOPGEN], 1u);
            else XB_SPIN(xb_ld(&bar[XB_TOPGEN]) == tg, bar);
            __builtin_amdgcn_fence(__ATOMIC_ACQUIRE, "agent");
            xb_add(&bar[XB_XGEN(b.x)], 1u);
            asm volatile("s_waitcnt vmcnt(0)" ::: "memory");
        } else {
            XB_SPIN(xb_ld(&bar[XB_XGEN(b.x)]) == gen, bar);
            __builtin_amdgcn_fence(__ATOMIC_ACQUIRE, "agent");
            asm volatile("s_waitcnt vmcnt(0)" ::: "memory");
        }
    }
    __syncthreads();
}

struct Args { const float* in[19]; float* out; unsigned char* ws; int ph_lo, ph_hi; };

struct MixP {
    const bf16_t* P;
    bf16_t* YS;
    int L;
    const float *conv_a, *ln_v_g, *ln_v_b, *b_s, *pool_scale, *conv_d, *conv_d_b, *ln_d_g, *ln_d_b;
    const bf16_t *WsB, *WpoolT, *WpwT;
};

__device__ __forceinline__ void mix_unit(const MixP& mp, LAS unsigned char* lds, int r0, int tid, int lane, int wave) {
    const bf16_t* P = mp.P; const int L = mp.L;
    const int fr = lane & 15, fq = lane >> 4;
    LAS float* HH = (LAS float*)lds;
    LAS bf16_t* AM = (LAS bf16_t*)(lds + R1_OFF);
    LAS float* CV = (LAS float*)(lds + R1_OFF);
    LAS bf16_t* AMD = (LAS bf16_t*)lds;
    LAS bf16_t* VN = (LAS bf16_t*)(lds + VN_OFF);
    const int seq0 = r0 & ~(L - 1);
#pragma unroll 1
    for (int it0 = tid; it0 < 64 * 32; it0 += 2 * NTHR) {
        u32x4 ld[2][8];
#pragma unroll
        for (int q = 0; q < 2; ++q) { const int it = it0 + q * NTHR, tok = it >> 5, oc = it & 31, r = r0 + tok, pos = r - seq0;
            const bf16_t* rp = P + (size_t)r * NC + oc * 8;
            const int dm = pos > 0 ? -NC : 0, dp = pos < L - 1 ? NC : 0;
            ld[q][0] = *(const u32x4*)(rp); ld[q][1] = *(const u32x4*)(rp + 256); ld[q][2] = *(const u32x4*)(rp + 512); ld[q][3] = *(const u32x4*)(rp + 768);
            ld[q][4] = *(const u32x4*)(rp + dm); ld[q][5] = *(const u32x4*)(rp + dm + 512); ld[q][6] = *(const u32x4*)(rp + dp); ld[q][7] = *(const u32x4*)(rp + dp + 512); }
#pragma unroll
        for (int q = 0; q < 2; ++q) { const int it = it0 + q * NTHR, tok = it >> 5, oc = it & 31, r = r0 + tok, pos = r - seq0;
            const float fm = pos > 0 ? 1.f : 0.f, fp = pos < L - 1 ? 1.f : 0.f;
            const float* wa = mp.conv_a + oc * 8;
            const f32x4 w0a = *(const f32x4*)(wa), w0b = *(const f32x4*)(wa + 4), w1a = *(const f32x4*)(wa + 256), w1b = *(const f32x4*)(wa + 260), w2a = *(const f32x4*)(wa + 512), w2b = *(const f32x4*)(wa + 516);
            const float w0[8] = {w0a[0] * fm, w0a[1] * fm, w0a[2] * fm, w0a[3] * fm, w0b[0] * fm, w0b[1] * fm, w0b[2] * fm, w0b[3] * fm};
            const float w1[8] = {w1a[0], w1a[1], w1a[2], w1a[3], w1b[0], w1b[1], w1b[2], w1b[3]};
            const float w2[8] = {w2a[0] * fp, w2a[1] * fp, w2a[2] * fp, w2a[3] * fp, w2b[0] * fp, w2b[1] * fp, w2b[2] * fp, w2b[3] * fp};
            UNPACK8(ld[q][0], h); UNPACK8(ld[q][1], bg); UNPACK8(ld[q][2], cgv); UNPACK8(ld[q][3], z); UNPACK8(ld[q][4], hmf); UNPACK8(ld[q][5], cmf); UNPACK8(ld[q][6], hpf); UNPACK8(ld[q][7], cpf);
            float y[8];
#pragma unroll
            for (int e = 0; e < 8; ++e) { const float cv = w0[e] * (cmf[e] * hmf[e]) + w1[e] * (cgv[e] * h[e]) + w2[e] * (cpf[e] * hpf[e]); y[e] = bg[e] * cv * silu(z[e]); }
            u32x4 o; o.x = pk2(y[0], y[1]); o.y = pk2(y[2], y[3]); o.z = pk2(y[4], y[5]); o.w = pk2(y[6], y[7]);
            *(u32x4*)(mp.YS + (size_t)r * D + oc * 8) = o; }
    }
    {
        const int tok = tid >> 3, o8 = tid & 7, r = r0 + tok, pos = r - seq0;
        const bf16_t* cb = P + (size_t)seq0 * NC + 7 * 256 + o8 * 8;
#define POOL_OUT(GI, WV, BASE, CT) do { const int half_ = 1 << (GI), lo_ = max(pos - half_, 0), hi_ = min(pos + half_, L), cnt_ = hi_ - lo_; \
            float s_[8] = {0.f, 0.f, 0.f, 0.f, 0.f, 0.f, 0.f, 0.f}; \
            _Pragma("unroll") for (int jj = 0; jj < 2 * half_; ++jj) { const float m_ = jj < cnt_ ? 1.f : 0.f; UNPACK8(WV[(BASE) + jj], f_); _Pragma("unroll") for (int e = 0; e < 8; ++e) s_[e] += m_ * f_[e]; } \
            UNPACK8(CT, c_); const float inv_ = 1.0f / (float)cnt_; \
            u32x4 o_; o_.x = pk2(s_[0] * inv_ - c_[0], s_[1] * inv_ - c_[1]); o_.y = pk2(s_[2] * inv_ - c_[2], s_[3] * inv_ - c_[3]); o_.z = pk2(s_[4] * inv_ - c_[4], s_[5] * inv_ - c_[5]); o_.w = pk2(s_[6] * inv_ - c_[6], s_[7] * inv_ - c_[7]); \
            *(LAS u32x4*)(AM + tok * AROW + (GI) * 64 + o8 * 8) = o_; } while (0)
#define POOL_LOAD(GI, WV, BASE, CT) do { const int half_ = 1 << (GI), lo_ = max(pos - half_, 0), hi_ = min(pos + half_, L); \
            _Pragma("unroll") for (int jj = 0; jj < 2 * half_; ++jj) WV[(BASE) + jj] = *(const u32x4*)(cb + (GI) * 64 + (size_t)min(lo_ + jj, hi_ - 1) * NC); \
            CT = *(const u32x4*)(cb + (GI) * 64 + (size_t)pos * NC); } while (0)
        {
            u32x4 wa[14], c0, c1, c2;
            POOL_LOAD(0, wa, 0, c0); POOL_LOAD(1, wa, 2, c1); POOL_LOAD(2, wa, 6, c2);
            POOL_OUT(0, wa, 0, c0); POOL_OUT(1, wa, 2, c1); POOL_OUT(2, wa, 6, c2);
        }
        {
            u32x4 wb[16], c3;
            POOL_LOAD(3, wb, 0, c3);
            POOL_OUT(3, wb, 0, c3);
        }
#undef POOL_OUT
#undef POOL_LOAD
    }
#pragma unroll 1
    for (int it0 = tid; it0 < 94 * 32; it0 += 3 * NTHR) {
        u32x4 la[3], lg[3];
#pragma unroll
        for (int q = 0; q < 3; ++q) { const int it = it0 + q * NTHR, j = it >> 5, oc = it & 31, r = r0 - 15 + j; const bool ok = it < 94 * 32 && r >= seq0 && r < seq0 + L;
            const bf16_t* rp = P + (size_t)(ok ? r : r0) * NC + 9 * 256 + oc * 8;
            la[q] = *(const u32x4*)(rp); lg[q] = *(const u32x4*)(rp + 256); }
#pragma unroll
        for (int q = 0; q < 3; ++q) { const int it = it0 + q * NTHR, j = it >> 5, oc = it & 31, r = r0 - 15 + j; const bool ok = r >= seq0 && r < seq0 + L;
            if (it < 94 * 32) {
                const float mk = ok ? 1.f : 0.f; UNPACK8(la[q], a); UNPACK8(lg[q], gg);
                const f32x4 o0 = (f32x4){mk * a[0] * sigm(gg[0]), mk * a[1] * sigm(gg[1]), mk * a[2] * sigm(gg[2]), mk * a[3] * sigm(gg[3])};
                const f32x4 o1 = (f32x4){mk * a[4] * sigm(gg[4]), mk * a[5] * sigm(gg[5]), mk * a[6] * sigm(gg[6]), mk * a[7] * sigm(gg[7])};
                *(LAS f32x4*)(HH + j * 256 + oc * 8) = o0; *(LAS f32x4*)(HH + j * 256 + oc * 8 + 4) = o1; } }
    }
    __syncthreads();
    {
        const int gi = wave >> 1;
        f32x4 acc[4][2];
#pragma unroll
        for (int rb = 0; rb < 4; ++rb) { acc[rb][0] = (f32x4){0.f, 0.f, 0.f, 0.f}; acc[rb][1] = acc[rb][0]; }
#pragma unroll
        for (int ks = 0; ks < 2; ++ks) {
            bf16x8 bfr[2], afr[4];
#pragma unroll
            for (int cj = 0; cj < 2; ++cj) bfr[cj] = *(const bf16x8*)(mp.WpoolT + (size_t)(gi * 64 + ((32 * wave + 16 * cj) & 63) + fr) * 64 + ks * 32 + fq * 8);
#pragma unroll
            for (int rb = 0; rb < 4; ++rb) afr[rb] = *(const LAS bf16x8*)(AM + (rb * 16 + fr) * AROW + gi * 64 + ks * 32 + fq * 8);
#pragma unroll
            for (int rb = 0; rb < 4; ++rb)
#pragma unroll
                for (int cj = 0; cj < 2; ++cj) acc[rb][cj] = MFMA16(bfr[cj], afr[rb], acc[rb][cj]);
        }
#pragma unroll
        for (int rb = 0; rb < 4; ++rb)
#pragma unroll
            for (int cj = 0; cj < 2; ++cj) { const int r = r0 + rb * 16 + fr, col = 32 * wave + 16 * cj + 4 * fq;
                const u32x2 vz = *(const u32x2*)(P + (size_t)r * NC + 8 * 256 + col); const f32x4 sc = *(const f32x4*)(mp.pool_scale + col);
                const float z0 = bflo(vz.x), z1 = bfhi(vz.x), z2 = bflo(vz.y), z3 = bfhi(vz.y);
                u32x2 o; o.x = pk2(acc[rb][cj][0] * sc[0] * silu(z0), acc[rb][cj][1] * sc[1] * silu(z1)); o.y = pk2(acc[rb][cj][2] * sc[2] * silu(z2), acc[rb][cj][3] * sc[3] * silu(z3));
                *(u32x2*)(mp.YS + (size_t)r * D + 512 + col) = o; }
    }
    __syncthreads();
    {
        const int c = tid & 255, hf = tid >> 8;
        f32x2 w2[16];
#pragma unroll
        for (int j = 0; j < 15; ++j) w2[j] = (f32x2){mp.conv_d[(2 * j) * 256 + c], mp.conv_d[(2 * j + 1) * 256 + c]};
        w2[15] = (f32x2){mp.conv_d[30 * 256 + c], 0.f};
        const float bias = mp.conv_d_b[c];
#pragma unroll 1
        for (int g4 = 0; g4 < 4; ++g4) {
            const LAS float* hp = HH + (hf * 32 + g4 * 8) * 256 + c;
            f32x2 E[19], O[19];
#pragma unroll
            for (int i = 0; i < 19; ++i) { E[i] = (f32x2){hp[(2 * i) * 256], hp[(2 * i + 1) * 256]}; O[i] = (f32x2){hp[(2 * i + 1) * 256], i < 18 ? hp[(2 * i + 2) * 256] : 0.f}; }
#pragma unroll
            for (int o = 0; o < 8; ++o) { f32x2 a2 = (f32x2){bias, 0.f};
#pragma unroll
                for (int j = 0; j < 16; ++j) a2 = __builtin_elementwise_fma(w2[j], (o & 1) ? O[(o + 2 * j - 1) / 2] : E[(o + 2 * j) / 2], a2);
                CV[(hf * 32 + g4 * 8 + o) * 256 + c] = a2[0] + a2[1]; }
            asm volatile("" ::: "memory");
        }
    }
    __syncthreads();
    {
        const int t4 = lane >> 4, pp = lane & 15;
        f32x4 gv[4], bv[4];
#pragma unroll
        for (int j = 0; j < 4; ++j) { gv[j] = *(const f32x4*)(mp.ln_d_g + 4 * pp + 64 * j); bv[j] = *(const f32x4*)(mp.ln_d_b + 4 * pp + 64 * j); }
#pragma unroll
        for (int it = 0; it < 2; ++it) { const int tok = wave * 8 + it * 4 + t4;
            f32x4 v[4]; float sm = 0.f;
#pragma unroll
            for (int j = 0; j < 4; ++j) { v[j] = *(const LAS f32x4*)(CV + tok * 256 + 4 * pp + 64 * j); sm += (v[j][0] + v[j][1]) + (v[j][2] + v[j][3]); }
            const float mean = red16(sm) * (1.f / 256.f); float sq = 0.f;
#pragma unroll
            for (int j = 0; j < 4; ++j) { v[j] = v[j] - mean; sq += (v[j][0] * v[j][0] + v[j][1] * v[j][1]) + (v[j][2] * v[j][2] + v[j][3] * v[j][3]); }
            const float rstd = 1.0f / sqrtf(red16(sq) * (1.f / 256.f) + LN_EPS);
#pragma unroll
            for (int j = 0; j < 4; ++j) { const f32x4 y = v[j] * rstd * gv[j] + bv[j];
                u32x2 o; o.x = pk2(silu(y[0]), silu(y[1])); o.y = pk2(silu(y[2]), silu(y[3]));
                *(LAS u32x2*)(AMD + tok * AROW + 4 * pp + 64 * j) = o; } }
    }
    __syncthreads();
    {
        f32x4 acc[4][2];
#pragma unroll
        for (int rb = 0; rb < 4; ++rb) { acc[rb][0] = (f32x4){0.f, 0.f, 0.f, 0.f}; acc[rb][1] = acc[rb][0]; }
#pragma unroll
        for (int ks = 0; ks < 8; ++ks) {
            bf16x8 bfr[2], afr[4];
#pragma unroll
            for (int cj = 0; cj < 2; ++cj) bfr[cj] = *(const bf16x8*)(mp.WpwT + (size_t)(32 * wave + 16 * cj + fr) * 256 + ks * 32 + fq * 8);
#pragma unroll
            for (int rb = 0; rb < 4; ++rb) afr[rb] = *(const LAS bf16x8*)(AMD + (rb * 16 + fr) * AROW + ks * 32 + fq * 8);
#pragma unroll
            for (int rb = 0; rb < 4; ++rb)
#pragma unroll
                for (int cj = 0; cj < 2; ++cj) acc[rb][cj] = MFMA16(bfr[cj], afr[rb], acc[rb][cj]);
        }
#pragma unroll
        for (int rb = 0; rb < 4; ++rb)
#pragma unroll
            for (int cj = 0; cj < 2; ++cj) { const int r = r0 + rb * 16 + fr, col = 32 * wave + 16 * cj + 4 * fq;
                const u32x2 vz = *(const u32x2*)(P + (size_t)r * NC + 11 * 256 + col);
                const float z0 = bflo(vz.x), z1 = bfhi(vz.x), z2 = bflo(vz.y), z3 = bfhi(vz.y);
                u32x2 o; o.x = pk2(acc[rb][cj][0] * silu(z0), acc[rb][cj][1] * silu(z1)); o.y = pk2(acc[rb][cj][2] * silu(z2), acc[rb][cj][3] * silu(z3));
                *(u32x2*)(mp.YS + (size_t)r * D + 768 + col) = o; }
    }
    const int rc = r0 & ~127, p0 = r0 & 127;
    {
        const int t4 = lane >> 4, pp = lane & 15;
        u32x2 vpre[4][4];
#pragma unroll
        for (int it = 0; it < 4; ++it)
#pragma unroll
            for (int j = 0; j < 4; ++j) vpre[it][j] = *(const u32x2*)(P + (size_t)(rc + wave * 16 + it * 4 + t4) * NC + 5 * 256 + 4 * pp + 64 * j);
        f32x4 gv[4], bv[4];
#pragma unroll
        for (int j = 0; j < 4; ++j) { gv[j] = *(const f32x4*)(mp.ln_v_g + 4 * pp + 64 * j); bv[j] = *(const f32x4*)(mp.ln_v_b + 4 * pp + 64 * j); }
#pragma unroll
        for (int it = 0; it < 4; ++it) { const int q = wave * 16 + it * 4 + t4;
            f32x4 v[4]; float sm = 0.f;
#pragma unroll
            for (int j = 0; j < 4; ++j) { const u32x2 vv = vpre[it][j]; v[j] = (f32x4){bflo(vv.x), bfhi(vv.x), bflo(vv.y), bfhi(vv.y)}; sm += (v[j][0] + v[j][1]) + (v[j][2] + v[j][3]); }
            const float mean = red16(sm) * (1.f / 256.f); float sq = 0.f;
#pragma unroll
            for (int j = 0; j < 4; ++j) { v[j] = v[j] - mean; sq += (v[j][0] * v[j][0] + v[j][1] * v[j][1]) + (v[j][2] * v[j][2] + v[j][3] * v[j][3]); }
            const float rstd = 1.0f / sqrtf(red16(sq) * (1.f / 256.f) + LN_EPS);
#pragma unroll
            for (int j = 0; j < 4; ++j) { const f32x4 y = v[j] * rstd * gv[j] + bv[j];
                u32x2 o; o.x = pk2(y[0], y[1]); o.y = pk2(y[2], y[3]);
                *(LAS u32x2*)(VN + q * VROW + 4 * pp + 64 * j) = o; } }
    }
    __syncthreads();
    {
        const int h = wave >> 1;
        f32x4 acc[4][2];
#pragma unroll
        for (int rb = 0; rb < 4; ++rb) { acc[rb][0] = (f32x4){0.f, 0.f, 0.f, 0.f}; acc[rb][1] = acc[rb][0]; }
#pragma unroll
        for (int ks = 0; ks < 4; ++ks) {
            bf16x8 xfr[2], yfr[4];
#pragma unroll
            for (int cj = 0; cj < 2; ++cj) { const LAS bf16_t* vp = VN + (ks * 32 + fq * 8) * VROW + 32 * wave + 16 * cj + fr;
#pragma unroll
                for (int jj = 0; jj < 8; ++jj) xfr[cj][jj] = (short)vp[jj * VROW]; }
#pragma unroll
            for (int rb = 0; rb < 4; ++rb) yfr[rb] = *(const bf16x8*)(mp.WsB + (size_t)(h * 128 + p0 + rb * 16 + fr) * 128 + ks * 32 + fq * 8);
#pragma unroll
            for (int rb = 0; rb < 4; ++rb)
#pragma unroll
                for (int cj = 0; cj < 2; ++cj) acc[rb][cj] = MFMA16(xfr[cj], yfr[rb], acc[rb][cj]);
        }
#pragma unroll
        for (int rb = 0; rb < 4; ++rb) { const int p = p0 + rb * 16 + fr, r = rc + p; const float bias = mp.b_s[h * 128 + p];
#pragma unroll
            for (int cj = 0; cj < 2; ++cj) { const int col = 32 * wave + 16 * cj + 4 * fq;
                const u32x2 vu = *(const u32x2*)(P + (size_t)r * NC + 4 * 256 + col), vz = *(const u32x2*)(P + (size_t)r * NC + 6 * 256 + col);
                const float u0 = bflo(vu.x), u1 = bfhi(vu.x), u2 = bflo(vu.y), u3 = bfhi(vu.y), z0 = bflo(vz.x), z1 = bfhi(vz.x), z2 = bflo(vz.y), z3 = bfhi(vz.y);
                u32x2 o; o.x = pk2(u0 * (acc[rb][cj][0] + bias) * silu(z0), u1 * (acc[rb][cj][1] + bias) * silu(z1));
                o.y = pk2(u2 * (acc[rb][cj][2] + bias) * silu(z2), u3 * (acc[rb][cj][3] + bias) * silu(z3));
                *(u32x2*)(mp.YS + (size_t)r * D + 256 + col) = o; } }
    }
    __syncthreads();
}

__device__ __forceinline__ void final_ln(float* out, const float* stats, const float* lg, const float* lb, int vcu, int G, int tid) {
    const size_t n4 = (size_t)TS * 256, gt = (size_t)vcu * NTHR + tid, NGT = (size_t)G * NTHR;
    f32x4* o4 = (f32x4*)out;
#pragma unroll 1
    for (size_t i0 = gt; i0 < n4; i0 += 8 * NGT) {
        f32x4 v[8];
#pragma unroll
        for (int q = 0; q < 8; ++q) { const size_t i = i0 + q * NGT; v[q] = o4[i < n4 ? i : i0]; }
#pragma unroll
        for (int q = 0; q < 8; ++q) { const size_t i = i0 + q * NGT;
            if (i < n4) { const size_t row = i >> 8; const int c4 = (int)(i & 255);
                const float sm = stats[2 * row], sq = stats[2 * row + 1];
                const float mu = sm * (1.f / 1024.f), rstd = 1.0f / sqrtf(fmaxf(sq * (1.f / 1024.f) - mu * mu, 0.f) + LN_EPS);
                o4[i] = (v[q] - mu) * rstd * ((const f32x4*)lg)[c4] + ((const f32x4*)lb)[c4]; } }
    }
}

__global__ void __launch_bounds__(NTHR, 2) fwd_megakernel(Args args_unused) {
    extern __shared__ __attribute__((aligned(16))) unsigned char lds_raw[];
    LAS unsigned char* lds = (LAS unsigned char*)lds_raw;
    cg::grid_group grid = cg::this_grid();
    const int G = gridDim.x, bx = blockIdx.x;
    const int vcu = (G % 8 == 0) ? (bx % 8) * (G / 8) + bx / 8 : bx;
    typedef const __attribute__((address_space(4))) Args* KArgs;
#define PH_TID int tid = threadIdx.x; asm volatile("" : "+v"(tid)); const int lane = tid & 63, wave = __builtin_amdgcn_readfirstlane(tid >> 6); (void)lane; (void)wave; \
    KArgs ka = (KArgs)__builtin_amdgcn_kernarg_segment_ptr(); asm volatile("" : "+s"(ka)); \
    unsigned char* ws = ka->ws; \
    bf16_t* WinT = (bf16_t*)(ws + WS_WIN); bf16_t* WbrT = (bf16_t*)(ws + WS_WBR); bf16_t* WoutT = (bf16_t*)(ws + WS_WOUT); \
    bf16_t* WpwT = (bf16_t*)(ws + WS_WPW); bf16_t* WpoolT = (bf16_t*)(ws + WS_WPOOL); bf16_t* WsB = (bf16_t*)(ws + WS_WS); \
    bf16_t* XB = (bf16_t*)(ws + WS_XB); bf16_t* XB1 = (bf16_t*)(ws + WS_XB1); bf16_t* PROJ = (bf16_t*)(ws + WS_PROJ); \
    bf16_t* YS = (bf16_t*)(ws + WS_YS); bf16_t* MRG = (bf16_t*)(ws + WS_MRG); float* PRE = (float*)(ws + WS_PRE); \
    float* CS = (float*)(ws + WS_CSBW); float* BW = CS + NC; float* STATS = (float*)(ws + WS_STATS); \
    (void)WinT; (void)WbrT; (void)WoutT; (void)WpwT; (void)WpoolT; (void)WsB; (void)XB; (void)XB1; (void)PROJ; (void)YS; (void)MRG; (void)PRE; (void)CS; (void)BW; (void)STATS
#define SB_VARS const size_t row0 = (size_t)sb * TS; const bool prompt = row0 < (size_t)NPROMPT; \
    const float* xin = prompt ? ka->in[0] + row0 * D : ka->in[1] + (row0 - NPROMPT) * D; float* outp = ka->out + row0 * D; const int L = prompt ? 4096 : 16384; \
    float* st0 = STATS + 2 * row0; float* st1 = STATS + 2 * (size_t)TALL + 2 * row0; (void)xin; (void)outp; (void)L; (void)st0; (void)st1
    const int lo = args_unused.ph_lo, hi = args_unused.ph_hi;
    int ph = 0;
    if (threadIdx.x < 16) ((LAS unsigned*)(lds + XB_LDS_OFF))[threadIdx.x] = 0u;
    __syncthreads();
    const XcdBarrier xbar = xcd_barrier_post((unsigned*)args_unused.ws, (volatile LAS unsigned*)(lds + XB_LDS_OFF));
#define PH_IN (ph >= lo && ph < hi)
#define PH_END do { ++ph; if (ph > lo && ph < hi) { if (hi < 0) grid.sync(); else { for (int rb_ = 0; rb_ < REP_BAR; ++rb_) xcd_barrier(xbar); } } } while (0)

    if (PH_IN) {
        PH_TID;
        LAS float* scr = (LAS float*)(lds + wave * 16384);
        const int gw = vcu * NWAVES + wave, NGW = G * NWAVES;
        constexpr int I_IN = (D / 64) * (NC / 32), I_SQ = (D / 64) * (D / 32), I_PW = (256 / 64) * (256 / 32), I_PL = 2;
        constexpr int PER_L = I_IN + 2 * I_SQ + I_PW + 4 * I_PL, NITEMS = DEPTH * PER_L;
        for (int it = gw; it < NITEMS; it += NGW) {
            const int l = it / PER_L; int r = it % PER_L;
            if (r < I_IN) { transpose_item(ka->in[2] + (size_t)l * D * NC, D, NC, WinT + (size_t)l * NC * D, scr, r, lane, l == 1 ? ka->in[17] : nullptr, ka->in[18], CS, BW, true); continue; } r -= I_IN;
            if (r < I_SQ) { transpose_item(ka->in[15] + (size_t)l * D * D, D, D, WbrT + (size_t)l * D * D, scr, r, lane, nullptr, nullptr, nullptr, nullptr, false); continue; } r -= I_SQ;
            if (r < I_SQ) { transpose_item(ka->in[16] + (size_t)l * D * D, D, D, WoutT + (size_t)l * D * D, scr, r, lane, nullptr, nullptr, nullptr, nullptr, false); continue; } r -= I_SQ;
            if (r < I_PW) { transpose_item(ka->in[14] + (size_t)l * 65536, 256, 256, WpwT + (size_t)l * 65536, scr, r, lane, nullptr, nullptr, nullptr, nullptr, false); continue; } r -= I_PW;
            { const int gi = r / I_PL; transpose_item(ka->in[8] + (size_t)(l * 4 + gi) * 4096, 64, 64, WpoolT + (size_t)(l * 4 + gi) * 4096, scr, r % I_PL, lane, nullptr, nullptr, nullptr, nullptr, false); }
        }
        const size_t gt = (size_t)vcu * NTHR + tid, NGT = (size_t)G * NTHR;
        for (size_t i = gt; i < (size_t)2 * TALL * 2 / 4; i += NGT) ((f32x4*)STATS)[i] = (f32x4){0.f, 0.f, 0.f, 0.f};
        for (size_t i = gt; i < (size_t)DEPTH * 4 * 128 * 128 / 4; i += NGT) { const f32x4 v = *(const f32x4*)(ka->in[6] + 4 * i); u32x2 o; o.x = pk2(v[0], v[1]); o.y = pk2(v[2], v[3]); *(u32x2*)(WsB + 4 * i) = o; }
        for (size_t i0 = gt; i0 < (size_t)TALL * D / 8; i0 += 8 * NGT) {
            f32x4 a[8], b[8];
#pragma unroll
            for (int q = 0; q < 8; ++q) { const size_t i = i0 + q * NGT, e = 8 * (i < (size_t)TALL * D / 8 ? i : i0);
                const float* src = e < (size_t)NPROMPT * D ? ka->in[0] + e : ka->in[1] + (e - (size_t)NPROMPT * D);
                a[q] = *(const f32x4*)(src); b[q] = *(const f32x4*)(src + 4); }
#pragma unroll
            for (int q = 0; q < 8; ++q) { const size_t i = i0 + q * NGT;
                if (i < (size_t)TALL * D / 8) { u32x4 o; o.x = pk2(a[q][0], a[q][1]); o.y = pk2(a[q][2], a[q][3]); o.z = pk2(b[q][0], b[q][1]); o.w = pk2(b[q][2], b[q][3]);
                    *(u32x4*)(XB + 8 * i) = o; } }
        }
        __syncthreads();
    }
    PH_END;

    for (int sb = 0; sb < NSB; ++sb) {
        for (int l = 0; l < DEPTH; ++l) {
            for (int hf = 0; hf < 2; ++hf) {
                if (PH_IN) {
                    if (hf == 1) {
                        PH_TID; SB_VARS;
                        if (l == 0 && sb > 0) final_ln(outp - (size_t)TS * D, st1 - 2 * (size_t)TS, ka->in[17] + D, ka->in[18] + D, vcu, G, tid);
                        MixP mp;
                        mp.P = PROJ; mp.YS = YS; mp.L = L;
                        mp.conv_a = ka->in[3] + l * 3 * 256; mp.ln_v_g = ka->in[4] + l * 256; mp.ln_v_b = ka->in[5] + l * 256; mp.b_s = ka->in[7] + l * 512;
                        mp.pool_scale = ka->in[9] + l * 256; mp.conv_d = ka->in[10] + l * 31 * 256; mp.conv_d_b = ka->in[11] + l * 256; mp.ln_d_g = ka->in[12] + l * 256; mp.ln_d_b = ka->in[13] + l * 256;
                        mp.WsB = WsB + (size_t)l * 65536; mp.WpoolT = WpoolT + (size_t)l * 16384; mp.WpwT = WpwT + (size_t)l * 65536;
                        for (int rep = 0; rep < REP_MIX; ++rep) for (int u = vcu; u < TS / 64; u += G) mix_unit(mp, lds, u * 64, tid, lane, wave);
                    }
                    PH_TID; SB_VARS;
                    const int cofs = hf == 0 ? 0 : NBRC, ncol = hf == 0 ? NBRC : NC - NBRC;
                    pg8::Gemm g{l == 0 ? XB + row0 * D : XB1, WinT + (size_t)l * NC * D + (size_t)cofs * D};
                    pg8::StaticOrder S; S.init(TS, ncol, G, bx);
                    pg8::RepOrder<pg8::StaticOrder, REP_G1> R; R.S = S; R.n = (S.nwg - bx + G - 1) / G;
#define G1_CALL(FOLD_, SIG_, ST_) do { pg8::EpiStoreBf16<FOLD_, SIG_> E{PROJ + cofs, NC, ST_, CS + cofs, BW + cofs}; \
                        pg8::gemm_phase<pg8::EpiStoreBf16<FOLD_, SIG_>, pg8::RepOrder<pg8::StaticOrder, REP_G1>, true, 1024>(lds, g, R, E, tid); } while (0)
                    if (l == 0) { if (hf == 0) G1_CALL(false, false, nullptr); else G1_CALL(false, true, nullptr); }
                    else { if (hf == 0) G1_CALL(true, false, st0); else G1_CALL(true, true, st0); }
#undef G1_CALL
                }
                PH_END;
            }
            if (PH_IN) {
                PH_TID; SB_VARS;
                pg8::Gemm g{YS, WbrT + (size_t)l * D * D};
                pg8::SubOrder<4> S; S.S.init(TS, D, G, bx);
                pg8::EpiGate E{PROJ + 3072, NC, MRG, D};
                pg8::RepOrder<pg8::SubOrder<4>, REP_BR> R; R.S = S; R.n = 4 * ((S.S.nwg - bx + G - 1) / G);
                pg8::gemm_phase<pg8::EpiGate, pg8::RepOrder<pg8::SubOrder<4>, REP_BR>, true, 256>(lds, g, R, E, tid);
            }
            PH_END;
            if (PH_IN) {
                PH_TID; SB_VARS;
                pg8::Gemm g{MRG, WoutT + (size_t)l * D * D};
                pg8::StaticOrder S; S.init(TS, D, G, bx);
                pg8::RepOrder<pg8::StaticOrder, REP_OUT> R; R.S = S; R.n = (S.nwg - bx + G - 1) / G;
                if (l == 0) { pg8::EpiRes<false> E{xin, nullptr, nullptr, nullptr, PRE, XB1, st0, D, ALPHA};
                    pg8::gemm_phase<pg8::EpiRes<false>, pg8::RepOrder<pg8::StaticOrder, REP_OUT>, true, 1024>(lds, g, R, E, tid); }
                else { pg8::EpiRes<true> E{PRE, st0, ka->in[17], ka->in[18], outp, nullptr, st1, D, ALPHA};
                    pg8::gemm_phase<pg8::EpiRes<true>, pg8::RepOrder<pg8::StaticOrder, REP_OUT>, true, 1024>(lds, g, R, E, tid); }
            }
            if (!(l == DEPTH - 1 && sb + 1 < NSB)) PH_END;
        }
    }
    if (PH_IN) {
        PH_TID;
        final_ln(ka->out + (size_t)(NSB - 1) * TS * D, STATS + 2 * (size_t)TALL + 2 * (size_t)(NSB - 1) * TS, ka->in[17] + D, ka->in[18] + D, vcu, G, tid);
    }
#undef PH_IN
#undef PH_END
}

extern "C" void kernel_launch(void* const* d_in, const int* in_sizes, int n_in, void* d_out, int out_size, void* d_ws, size_t ws_size, hipStream_t stream) {
    static int grid = 0;
    if (grid == 0) {
        if (n_in != 19 || ws_size < WS_END || out_size != TALL * D) { fprintf(stderr, "kernel_launch: unexpected shapes (n_in %d, out %d, ws %zu)\n", n_in, out_size, ws_size); grid = -1; return; }
        int dev = 0, cus = 0, per_cu = 0;
        if (hipGetDevice(&dev) != hipSuccess || hipDeviceGetAttribute(&cus, hipDeviceAttributeMultiprocessorCount, dev) != hipSuccess) { grid = -1; return; }
        if (hipFuncSetAttribute((const void*)fwd_megakernel, hipFuncAttributeMaxDynamicSharedMemorySize, LDS_BYTES) != hipSuccess) { fprintf(stderr, "kernel_launch: hipFuncSetAttribute failed\n"); grid = -1; return; }
        if (hipOccupancyMaxActiveBlocksPerMultiprocessor(&per_cu, (const void*)fwd_megakernel, NTHR, LDS_BYTES) != hipSuccess || per_cu < 1) { fprintf(stderr, "kernel_launch: occupancy query says %d\n", per_cu); per_cu = 1; }
        (void)hipGetLastError();
        grid = cus * per_cu;
    }
    if (grid < 0) return;
    if (hipMemsetAsync(d_ws, 0, CTL_ZERO_BYTES, stream) != hipSuccess) { fprintf(stderr, "kernel_launch: memset failed\n"); return; }
    Args a{};
    for (int i = 0; i < 19; ++i) a.in[i] = (const float*)d_in[i];
    a.out = (float*)d_out; a.ws = (unsigned char*)d_ws; a.ph_lo = 0; a.ph_hi = 1 << 20;
    void* kargs[] = {&a};
    hipError_t e = hipLaunchCooperativeKernel((const void*)fwd_megakernel, dim3(grid), dim3(NTHR), kargs, LDS_BYTES, stream);
    if (e != hipSuccess) fprintf(stderr, "kernel_launch: cooperative launch failed: %s (grid %d)\n", hipGetErrorString(e), grid);
}
```

```cpp
#include <hip/hip_runtime.h>
#include <hip/hip_cooperative_groups.h>
#include <cstdio>
#include <cstdint>
namespace cg = cooperative_groups;

namespace pg8 {
#define PG8_LAS __attribute__((address_space(3)))
typedef unsigned short bf16_t;
typedef short bf16x8 __attribute__((ext_vector_type(8)));
typedef float f32x4 __attribute__((ext_vector_type(4)));
typedef unsigned u32x4 __attribute__((ext_vector_type(4)));
typedef unsigned u32x2 __attribute__((ext_vector_type(2)));
typedef float f32x2 __attribute__((ext_vector_type(2)));
constexpr int BM = 256, BK = 64, HALF = 128, HTB = HALF * BK * 2, STAGE_BYTES = 8 * HTB, NXCD = 8, WGM = 8;

__host__ __device__ __forceinline__ int lds_byte(int r, int c) { const int st = (r >> 4) * 2 + (c >> 5), rr = r & 15, cc = c & 31, ob = rr * 64 + cc * 2; return st * 1024 + (ob ^ (((ob >> 9) & 1) << 5)); }
__host__ __device__ __forceinline__ void stage_rc(int b, int& R, int& C) { const int st = b / 1024, sb = b % 1024, swz = sb ^ (((sb >> 9) & 1) << 5); R = (st >> 1) * 16 + swz / 64; C = (st & 1) * 32 + (swz % 64) / 2; }
__host__ __device__ __forceinline__ int perm32(int rho) { const int n = rho >> 4, i = rho & 15; return 8 * (i >> 2) + 4 * n + (i & 3); }

struct Unit { int pm, pn, kb; };
struct Gemm { const bf16_t* A; const bf16_t* Bt; };

struct StaticOrder {
    int nM, nN, nwg, G, c;
    __host__ __device__ void init(int M, int N, int G_, int c_) { nM = M / BM; nN = N / BM; nwg = nM * nN; G = G_; c = c_; }
    __host__ __device__ bool next(int i, Unit& u) const {
        const long L = (long)i * G + c; if (L >= nwg) return false;
        u.kb = 0;
        if (((G | nwg | nM) & 7) == 0) {
            const int wgid = (c & 7) * (nwg >> 3) + (c >> 3) + i * (G >> 3), nig = WGM * nN, gid = wgid / nig, rem = wgid - gid * nig;
            u.pm = gid * WGM + (rem & (WGM - 1)); u.pn = rem / WGM; return true;
        }
        int wgid = (int)L; { const int q = nwg / NXCD, r = nwg % NXCD, xcd = wgid % NXCD, off = wgid / NXCD; wgid = (xcd < r ? xcd * (q + 1) : r * (q + 1) + (xcd - r) * q) + off; }
        const int nig = WGM * nN, gid = wgid / nig, fm = gid * WGM, gsz = (nM - fm) < WGM ? (nM - fm) : WGM;
        u.pm = fm + ((wgid % nig) % gsz); u.pn = (wgid % nig) / gsz; return true;
    }
};
template <int NSUB> struct SubOrder {
    StaticOrder S;
    __host__ __device__ bool next(int i, Unit& u) const { if (!S.next(i / NSUB, u)) return false; u.kb = i % NSUB; return true; }
};

template <class Base, int REP> struct RepOrder {
    Base S; int n;
    __host__ __device__ bool next(int i, Unit& u) const { if constexpr (REP == 1) return S.next(i, u); else { if (i >= REP * n) return false; return S.next(i % n, u); } }
};
__device__ __forceinline__ unsigned cvt_pk_bf16(float lo, float hi) { unsigned r; asm volatile("v_cvt_pk_bf16_f32 %0, %1, %2" : "=v"(r) : "v"(lo), "v"(hi)); return r; }
__device__ __forceinline__ float sigm(float x) { return __builtin_amdgcn_rcpf(1.f + __expf(-x)); }
__device__ __forceinline__ float bflo(unsigned w) { return __uint_as_float(w << 16); }
__device__ __forceinline__ float bfhi(unsigned w) { return __uint_as_float(w & 0xffff0000u); }

#define PG8_ZERO_ACC(acc) do { _Pragma("unroll") for (int a_ = 0; a_ < 2; ++a_) _Pragma("unroll") for (int b_ = 0; b_ < 2; ++b_) _Pragma("unroll") for (int m_ = 0; m_ < 4; ++m_) _Pragma("unroll") for (int n_ = 0; n_ < 2; ++n_) acc[a_][b_][m_][n_] = (f32x4){0.f, 0.f, 0.f, 0.f}; } while (0)

template <bool FOLD, bool SIG> struct EpiStoreBf16 {
    static constexpr bool PERM = true;
    bf16_t* O; int ldc;
    const float* stats;
    const float* cs; const float* bw;
    __device__ __forceinline__ void operator()(f32x4 (&acc)[2][2][4][2], const Unit& u, int wr, int wc, int fr, int fq) const {
        const int row0 = u.pm * BM + wr * 64 + fr, col0 = u.pn * BM + wc * 32 + 8 * fq;
        if constexpr (FOLD) {
            float mu[2][4], rs[2][4];
#pragma unroll
            for (int ai = 0; ai < 2; ++ai)
#pragma unroll
                for (int m = 0; m < 4; ++m) { const size_t row = (size_t)(row0 + ai * HALF + m * 16);
                    const float sm = stats[2 * row], sq = stats[2 * row + 1];
                    mu[ai][m] = sm * (1.f / 1024.f); rs[ai][m] = __builtin_amdgcn_rsqf(fmaxf(sq * (1.f / 1024.f) - mu[ai][m] * mu[ai][m], 0.f) + 1e-5f); }
            f32x4 c4[2][2], b4[2][2];
#pragma unroll
            for (int bj = 0; bj < 2; ++bj)
#pragma unroll
                for (int n = 0; n < 2; ++n) { c4[bj][n] = *(const f32x4*)(cs + col0 + bj * HALF + 4 * n); b4[bj][n] = *(const f32x4*)(bw + col0 + bj * HALF + 4 * n); }
#pragma unroll
            for (int bj = 0; bj < 2; ++bj)
#pragma unroll
                for (int n = 0; n < 2; ++n)
#pragma unroll
                    for (int ai = 0; ai < 2; ++ai)
#pragma unroll
                        for (int m = 0; m < 4; ++m) acc[ai][bj][m][n] = (acc[ai][bj][m][n] - c4[bj][n] * mu[ai][m]) * rs[ai][m] + b4[bj][n];
        }
        if constexpr (SIG) {
            char* gt_ = (char*)(O + (size_t)(u.pm * BM) * ldc + u.pn * 64);
            const unsigned gl_ = (unsigned)((wr * 64 + fr) * ldc + wc * 16 + 4 * fq) * 2u;
#pragma unroll
            for (int ai = 0; ai < 2; ++ai)
#pragma unroll
                for (int m = 0; m < 4; ++m) {
                    f32x4 tq[4], sg[4];
#pragma unroll
                    for (int i = 0; i < 4; ++i) { const f32x4 v = acc[ai][i >> 1][m][i & 1];
#pragma unroll
                        for (int e = 0; e < 4; ++e) { tq[i][e] = 1.f + __builtin_amdgcn_exp2f(fmaxf(v[e], -30.f) * -1.4426950408889634f); sg[i][e] = __builtin_amdgcn_rcpf(tq[i][e]); } }
                    char* rowp = gt_ + (size_t)((ai * HALF + m * 16) * ldc) * 2;
#pragma unroll
                    for (int i = 0; i < 4; ++i) { const f32x4 r = i < 3 ? sg[i] * tq[i < 3 ? i + 1 : 3] : sg[3];
                        u32x2 w; w.x = cvt_pk_bf16(r[0], r[1]); w.y = cvt_pk_bf16(r[2], r[3]);
                        *(u32x2*)(rowp + i * 2048 + gl_) = w; }
                }
        } else {
        char* tile = (char*)(O + (size_t)(u.pm * BM) * ldc + u.pn * BM);
        const unsigned lofs = (unsigned)((wr * 64 + fr) * ldc + wc * 32 + 8 * fq) * 2u;
#pragma unroll
        for (int ai = 0; ai < 2; ++ai)
#pragma unroll
            for (int m = 0; m < 4; ++m) { char* rowp = tile + (size_t)((ai * HALF + m * 16) * ldc) * 2;
#pragma unroll
                for (int bj = 0; bj < 2; ++bj) { const f32x4 v0 = acc[ai][bj][m][0], v1 = acc[ai][bj][m][1];
                    u32x4 w; w.x = cvt_pk_bf16(v0[0], v0[1]); w.y = cvt_pk_bf16(v0[2], v0[3]); w.z = cvt_pk_bf16(v1[0], v1[1]); w.w = cvt_pk_bf16(v1[2], v1[3]);
                    *(u32x4*)(rowp + bj * HALF * 2 + lofs) = w; } }
        }
        PG8_ZERO_ACC(acc);
    }
};

struct EpiGate {
    static constexpr bool PERM = true;
    const bf16_t* Gt; int ldg;
    bf16_t* O; int ldc;
    __device__ __forceinline__ void operator()(f32x4 (&acc)[2][2][4][2], const Unit& u, int wr, int wc, int fr, int fq) const {
        const bool last = u.kb == 3;
        const char* gtile = (const char*)(Gt + (size_t)(u.pm * BM) * ldg + u.kb * 1024 + u.pn * BM);
        char* otile = (char*)(O + (size_t)(u.pm * BM) * ldc + u.pn * BM);
        int frl = fr; asm volatile("" : "+v"(frl));
        const unsigned glofs = (unsigned)((wr * 64 + frl) * ldg + wc * 32 + 8 * fq) * 2u, olofs = (unsigned)((wr * 64 + frl) * ldc + wc * 32 + 8 * fq) * 2u;
        const float keep = last ? 0.f : 1.f;
        u32x4 ga[2][4][2];
#pragma unroll
        for (int ai = 0; ai < 2; ++ai)
#pragma unroll
            for (int m = 0; m < 4; ++m)
#pragma unroll
                for (int bj = 0; bj < 2; ++bj) ga[ai][m][bj] = *(const u32x4*)(gtile + (size_t)((ai * HALF + m * 16) * ldg + bj * HALF) * 2 + glofs);
#pragma unroll
        for (int ai = 0; ai < 2; ++ai) {
#pragma unroll
            for (int m = 0; m < 4; ++m)
#pragma unroll
                for (int bj = 0; bj < 2; ++bj) {
                    const u32x4 va = ga[ai][m][bj];
                    f32x4 v0 = acc[ai][bj][m][0], v1 = acc[ai][bj][m][1];
                    v0[0] *= bflo(va.x); v0[1] *= bfhi(va.x); v0[2] *= bflo(va.y); v0[3] *= bfhi(va.y); v1[0] *= bflo(va.z); v1[1] *= bfhi(va.z); v1[2] *= bflo(va.w); v1[3] *= bfhi(va.w);
                    if (last) {
                        u32x4 w; w.x = cvt_pk_bf16(v0[0], v0[1]); w.y = cvt_pk_bf16(v0[2], v0[3]); w.z = cvt_pk_bf16(v1[0], v1[1]); w.w = cvt_pk_bf16(v1[2], v1[3]);
                        *(u32x4*)(otile + (size_t)((ai * HALF + m * 16) * ldc + bj * HALF) * 2 + olofs) = w;
                    }
                    acc[ai][bj][m][0] = v0 * keep; acc[ai][bj][m][1] = v1 * keep;
                }
            asm volatile("" ::: "memory");
        }
    }
};

template <bool L1> struct EpiRes {
    static constexpr bool PERM = false;
    const float* base; const float* bstats; const float* lg; const float* lb;
    float* O; bf16_t* XO; float* ostats; int ldc; float alpha;
    __device__ __forceinline__ void operator()(f32x4 (&acc)[2][2][4][2], const Unit& u, int wr, int wc, int fr, int fq) const {
        const int row0 = u.pm * BM + wr * 64 + fr, col0 = u.pn * BM + wc * 32 + 4 * fq;
        const char* btile = (const char*)(base + (size_t)(u.pm * BM) * ldc + u.pn * BM); char* otile = (char*)(O + (size_t)(u.pm * BM) * ldc + u.pn * BM);
        char* xtile = (char*)(XO + (size_t)(u.pm * BM) * ldc + u.pn * BM);
        const unsigned lofs = (unsigned)((wr * 64 + fr) * ldc + wc * 32 + 4 * fq) * 4u;
        f32x4 g4[2][2], b4[2][2];
        if constexpr (L1) {
#pragma unroll
            for (int bj = 0; bj < 2; ++bj)
#pragma unroll
                for (int n = 0; n < 2; ++n) { g4[bj][n] = *(const f32x4*)(lg + col0 + bj * HALF + n * 16); b4[bj][n] = *(const f32x4*)(lb + col0 + bj * HALF + n * 16); }
        }
        constexpr int NB = L1 ? 2 : 4;
#pragma unroll
        for (int aim = 0; aim < 8 / NB; ++aim) { const int ai = (aim * NB) >> 2, mh = (aim * NB) & 3;
            f32x4 xv[NB][2][2];
#pragma unroll
            for (int mm = 0; mm < NB; ++mm)
#pragma unroll
                for (int bj = 0; bj < 2; ++bj)
#pragma unroll
                    for (int n = 0; n < 2; ++n) xv[mm][bj][n] = *(const f32x4*)(btile + (size_t)((ai * HALF + (mh + mm) * 16) * ldc + bj * HALF + n * 16) * 4 + lofs);
            float mu2[NB], rs2[NB];
#pragma unroll
            for (int mm = 0; mm < NB; ++mm) { mu2[mm] = 0.f; rs2[mm] = 1.f; }
            if constexpr (L1) {
                f32x2 st2[NB];
#pragma unroll
                for (int mm = 0; mm < NB; ++mm) st2[mm] = *(const f32x2*)(bstats + 2 * (size_t)(row0 + ai * HALF + (mh + mm) * 16));
#pragma unroll
                for (int mm = 0; mm < NB; ++mm) { mu2[mm] = st2[mm][0] * (1.f / 1024.f); rs2[mm] = __builtin_amdgcn_rsqf(fmaxf(st2[mm][1] * (1.f / 1024.f) - mu2[mm] * mu2[mm], 0.f) + 1e-5f); }
            }
#pragma unroll
            for (int mm = 0; mm < NB; ++mm) { const int m = mh + mm; const size_t row = (size_t)(row0 + ai * HALF + m * 16); const size_t uo = (size_t)((ai * HALF + m * 16) * ldc);
                f32x4 ps4 = (f32x4){0.f, 0.f, 0.f, 0.f}, pq4 = ps4;
#pragma unroll
                for (int bj = 0; bj < 2; ++bj)
#pragma unroll
                    for (int n = 0; n < 2; ++n) { f32x4 x = xv[mm][bj][n];
                        if constexpr (L1) x = (x - mu2[mm]) * rs2[mm] * g4[bj][n] + b4[bj][n];
                        const f32x4 v = x * alpha + acc[ai][bj][m][n];
                        *(f32x4*)(otile + (uo + bj * HALF + n * 16) * 4 + lofs) = v;
                        if constexpr (!L1) { u32x2 w; w.x = cvt_pk_bf16(v[0], v[1]); w.y = cvt_pk_bf16(v[2], v[3]); *(u32x2*)(xtile + (uo + bj * HALF + n * 16) * 2 + (lofs >> 1)) = w; }
                        ps4 += v; pq4 += v * v; }
                float ps = (ps4[0] + ps4[1]) + (ps4[2] + ps4[3]), pq = (pq4[0] + pq4[1]) + (pq4[2] + pq4[3]);
                ps += __shfl_xor(ps, 16); ps += __shfl_xor(ps, 32); pq += __shfl_xor(pq, 16); pq += __shfl_xor(pq, 32);
                if (fq == 0) { atomicAdd(ostats + 2 * row, ps); atomicAdd(ostats + 2 * row + 1, pq); } }
            asm volatile("" ::: "memory");
        }
        PG8_ZERO_ACC(acc);
    }
};

template <class Epi, class Sched, bool ALIGN_EPI, int KU>
__device__ __forceinline__ void gemm_phase(PG8_LAS unsigned char* lds, const Gemm g, const Sched& S, const Epi& E, const int tid) {
    const int wid = __builtin_amdgcn_readfirstlane(tid >> 6), lane = tid & 63, wr = wid >> 2, wc = wid & 3, fr = lane & 15, fq = lane >> 4;
    constexpr int K = KU, nt = K / BK, LD = 1024;
    unsigned voffA[2], voffB[2];
#pragma unroll
    for (int i = 0; i < 2; ++i) { int R, C; stage_rc(tid * 16 + i * 8192, R, C); const int Rb = Epi::PERM ? ((R & ~31) + perm32(R & 31)) : R;
        voffA[i] = (unsigned)(R * LD + C) * 2u; voffB[i] = (unsigned)(Rb * LD + C) * 2u; }
    constexpr size_t kstep = (size_t)(BK * 2);
    constexpr size_t hstepA = (size_t)HALF * LD * 2, hstepB = hstepA;
    constexpr size_t tstepA = 2 * hstepA, tstepB = 2 * hstepB;
    constexpr size_t ksub = (size_t)K * 2;
    const unsigned ldsw = (unsigned)wid * 1024u;
    const int aoff = lds_byte(wr * 64 + fr, fq * 8), boff = lds_byte(wc * 32 + fr, fq * 8);
#define PG8_SA(b, h) (((b) * 2 + (h)) * HTB)
#define PG8_SB(b, h) ((4 + (b) * 2 + (h)) * HTB)
#define PG8_STAGE(bufoff, gbase, voff) do { _Pragma("unroll") for (int _i = 0; _i < 2; ++_i) \
        __builtin_amdgcn_global_load_lds((const unsigned*)((const char*)(gbase) + (voff)[_i]), (PG8_LAS unsigned*)(lds + (bufoff) + ldsw + _i * 8192), 16, 0, 0); } while (0)
#define PG8_LDA(dst, b, h) do { _Pragma("unroll") for (int m = 0; m < 4; ++m) _Pragma("unroll") for (int k = 0; k < 2; ++k) dst[m][k] = *(const PG8_LAS bf16x8*)(lds + PG8_SA(b, h) + aoff + m * 2048 + k * 1024); } while (0)
#define PG8_LDB(dst, b, h) do { _Pragma("unroll") for (int n = 0; n < 2; ++n) _Pragma("unroll") for (int k = 0; k < 2; ++k) dst[n][k] = *(const PG8_LAS bf16x8*)(lds + PG8_SB(b, h) + boff + n * 2048 + k * 1024); } while (0)
#define PG8_MMA(ai, bj, At, Bt) do { __builtin_amdgcn_s_setprio(1); _Pragma("unroll") for (int m = 0; m < 4; ++m) _Pragma("unroll") for (int n = 0; n < 2; ++n) _Pragma("unroll") for (int k = 0; k < 2; ++k) \
        acc[ai][bj][m][n] = __builtin_amdgcn_mfma_f32_16x16x32_bf16(Bt[n][k], At[m][k], acc[ai][bj][m][n], 0, 0, 0); __builtin_amdgcn_s_setprio(0); } while (0)
#define PG8_WAIT_V(n) asm volatile("s_waitcnt vmcnt(" #n ")" ::: "memory")
#define PG8_WAIT_L(n) asm volatile("s_waitcnt lgkmcnt(" #n ")" ::: "memory")
#define PG8_BAR __builtin_amdgcn_s_barrier()
#define PG8_SCHED __builtin_amdgcn_sched_barrier(0)
    Unit cur, nxt; int ui = 0;
    if (!S.next(0, cur)) return;
    f32x4 acc[2][2][4][2];
    PG8_ZERO_ACC(acc);
    bf16x8 At[4][2], B0[2][2], B1[2][2];
    const char* cA = (const char*)g.A + (size_t)cur.pm * tstepA + (size_t)cur.kb * ksub; const char* cB = (const char*)g.Bt + (size_t)cur.pn * tstepB + (size_t)cur.kb * ksub;
    PG8_STAGE(PG8_SB(0, 0), cB, voffB); PG8_STAGE(PG8_SB(0, 1), cB + hstepB, voffB); PG8_STAGE(PG8_SA(0, 0), cA, voffA); PG8_STAGE(PG8_SA(0, 1), cA + hstepA, voffA);
    if (wr == 1) PG8_BAR;
    PG8_WAIT_V(2); PG8_BAR;
    PG8_STAGE(PG8_SB(1, 0), cB + kstep, voffB); PG8_STAGE(PG8_SA(1, 0), cA + kstep, voffA); PG8_STAGE(PG8_SB(1, 1), cB + hstepB + kstep, voffB);
    PG8_WAIT_V(6); PG8_BAR;
    for (;;) {
        const bool has_next = S.next(ui + 1, nxt);
        const char* nA = has_next ? (const char*)g.A + (size_t)nxt.pm * tstepA + (size_t)nxt.kb * ksub : cA;
        const char* nB = has_next ? (const char*)g.Bt + (size_t)nxt.pn * tstepB + (size_t)nxt.kb * ksub : cB;
        for (int t = 0; t < nt; t += 2) {
            const bool last = (t == nt - 2);
            const char* a1 = cA + (size_t)(t + 1) * kstep;
            const char* a2 = last ? nA : cA + (size_t)(t + 2) * kstep; const char* b2 = last ? nB : cB + (size_t)(t + 2) * kstep;
            const char* a3 = a2 + kstep; const char* b3 = b2 + kstep;
            PG8_LDB(B0, 0, 0); PG8_LDB(B1, 0, 1); PG8_SCHED; PG8_LDA(At, 0, 0); PG8_STAGE(PG8_SA(1, 1), a1 + hstepA, voffA);
            PG8_WAIT_V(8); PG8_WAIT_L(0); PG8_BAR; PG8_MMA(0, 0, At, B0); PG8_MMA(0, 1, At, B1); PG8_BAR; PG8_SCHED;
            PG8_LDA(At, 0, 1); PG8_STAGE(PG8_SB(0, 0), b2, voffB); PG8_STAGE(PG8_SB(0, 1), b2 + hstepB, voffB); PG8_STAGE(PG8_SA(0, 0), a2, voffA);
            PG8_WAIT_V(8); PG8_WAIT_L(0); PG8_BAR; PG8_MMA(1, 0, At, B0); PG8_MMA(1, 1, At, B1); PG8_BAR; PG8_SCHED;
            PG8_LDB(B0, 1, 0); PG8_LDB(B1, 1, 1); PG8_SCHED; PG8_LDA(At, 1, 0); PG8_STAGE(PG8_SA(0, 1), a2 + hstepA, voffA);
            PG8_WAIT_V(8); PG8_WAIT_L(0); PG8_BAR; PG8_MMA(0, 0, At, B0); PG8_MMA(0, 1, At, B1); PG8_BAR; PG8_SCHED;
            PG8_LDA(At, 1, 1); PG8_STAGE(PG8_SB(1, 0), b3, voffB); PG8_STAGE(PG8_SB(1, 1), b3 + hstepB, voffB); PG8_STAGE(PG8_SA(1, 0), a3, voffA);
            PG8_WAIT_V(8); PG8_WAIT_L(0); PG8_BAR; PG8_MMA(1, 0, At, B0); PG8_MMA(1, 1, At, B1); PG8_BAR; PG8_SCHED;
        }
        if constexpr (ALIGN_EPI) { if (wr == 0) PG8_BAR; }
        E(acc, cur, wr, wc, fr, fq);
        if (!has_next) break;
        cur = nxt; cA = nA; cB = nB; ++ui;
        if constexpr (ALIGN_EPI) { if (wr == 1) PG8_BAR; }
    }
    PG8_WAIT_V(0);
    if constexpr (!ALIGN_EPI) { if (wr == 0) PG8_BAR; }
    PG8_BAR;
#undef PG8_SA
#undef PG8_SB
#undef PG8_STAGE
#undef PG8_LDA
#undef PG8_LDB
#undef PG8_MMA
#undef PG8_WAIT_V
#undef PG8_WAIT_L
#undef PG8_BAR
#undef PG8_SCHED
}
}

#ifndef REP_G1
#define REP_G1 1
#endif
#ifndef REP_MIX
#define REP_MIX 1
#endif
#ifndef REP_BR
#define REP_BR 1
#endif
#ifndef REP_OUT
#define REP_OUT 1
#endif
#ifndef REP_BAR
#define REP_BAR 1
#endif
#ifndef REP_LN
#define REP_LN 1
#endif
using pg8::bf16_t; using pg8::bf16x8; using pg8::f32x4; using pg8::u32x4; using pg8::u32x2;
#define LAS __attribute__((address_space(3)))
constexpr int NWAVES = 8, NTHR = 512;
#ifndef TS_ROWS
#define TS_ROWS 16384
#endif
constexpr int D = 1024, NC = 7168, NBRC = 3072, TS = TS_ROWS, TALL = 81920, NSB = TALL / TS, NPROMPT = 65536, DEPTH = 2;
constexpr float LN_EPS = 1e-5f, ALPHA = 1.41421356237309515f;
constexpr size_t MiB = 1u << 20;
constexpr size_t WS_WIN = 1 * MiB, WS_WBR = 29 * MiB, WS_WOUT = 33 * MiB, WS_WPW = 37 * MiB, WS_WPOOL = 38 * MiB, WS_WS = 39 * MiB;
constexpr size_t WS_CSBW = 65536, WS_STATS = 40 * MiB, STATS_BYTES = 2 * MiB;
constexpr size_t WS_XB = 42 * MiB, WS_XB1 = 202 * MiB, WS_PROJ = WS_XB1 + (size_t)TS * D * 2, WS_YS = WS_PROJ + (size_t)TS * NC * 2, WS_MRG = WS_YS + (size_t)TS * D * 2,
                 WS_PRE = WS_MRG + (size_t)TS * D * 2, WS_END = WS_PRE + (size_t)TS * D * 4;
constexpr int LDS_BYTES = 161792 + 64;
constexpr int XB_LDS_OFF = 161792;
constexpr size_t CTL_ZERO_BYTES = 131072;
constexpr int R1_OFF = 96256, VN_OFF = 34816, AROW = 264, VROW = 272;

__device__ __forceinline__ float wave_sum(float v) {
#pragma unroll
    for (int o = 1; o < 64; o <<= 1) v += __shfl_xor(v, o);
    return v;
}
__device__ __forceinline__ float red16(float v) {
    v += __shfl_xor(v, 1); v += __shfl_xor(v, 2); v += __shfl_xor(v, 4); v += __shfl_xor(v, 8); return v;
}
__device__ __forceinline__ unsigned f2bf(float f) { unsigned u = __builtin_bit_cast(unsigned, f); return (u + 0x7fffu + ((u >> 16) & 1u)) >> 16; }
__device__ __forceinline__ unsigned pk2(float lo, float hi) { return f2bf(lo) | (f2bf(hi) << 16); }
__device__ __forceinline__ float sigm(float x) { return __builtin_amdgcn_rcpf(1.f + __expf(-x)); }
__device__ __forceinline__ float silu(float x) { return x * sigm(x); }
__device__ __forceinline__ float bflo(unsigned w) { return __uint_as_float(w << 16); }
__device__ __forceinline__ float bfhi(unsigned w) { return __uint_as_float(w & 0xffff0000u); }
#define UNPACK8(v, f) float f[8] = {bflo((v).x), bfhi((v).x), bflo((v).y), bfhi((v).y), bflo((v).z), bfhi((v).z), bflo((v).w), bfhi((v).w)}
#define MFMA16(x, y, c) __builtin_amdgcn_mfma_f32_16x16x32_bf16((x), (y), (c), 0, 0, 0)

__device__ __forceinline__ int gate_src_col(int nout) {
    const int c = nout - 3072, t = c >> 8, r = c & 255, bj = r >> 7, wc = (r >> 5) & 3, fq = (r >> 3) & 3, n = (r >> 2) & 1, e = r & 3;
    return 3072 + (2 * bj + n) * 1024 + 64 * t + 16 * wc + 4 * fq + e;
}
__device__ __forceinline__ void transpose_item(const float* W, int K, int N, bf16_t* WT, LAS float* scr, int item, int lane, const float* gs, const float* bs, float* cs, float* bw, bool gperm) {
    const int nblk = N / 32, kb = item / nblk, nb = item % nblk, k0 = 64 * kb, n0 = 32 * nb;
    const int scol = (gperm && n0 >= 3072) ? gate_src_col(n0 + (lane & 31)) : n0 + (lane & 31);
#pragma unroll 8
    for (int i = 0; i < 32; ++i) { const int kk = 2 * i + (lane >> 5); scr[kk * 33 + (lane & 31)] = W[(size_t)(k0 + kk) * N + scol]; }
    asm volatile("s_waitcnt lgkmcnt(0)" ::: "memory");
    const int c = lane & 7;
    float gsc[8] = {1.f, 1.f, 1.f, 1.f, 1.f, 1.f, 1.f, 1.f};
    if (gs) {
        float ca = 0.f, ba = 0.f; const int kh = (lane >> 5) * 32, nn = lane & 31;
#pragma unroll 8
        for (int kk = 0; kk < 32; ++kk) { const float w = scr[(kh + kk) * 33 + nn]; ca += __uint_as_float(f2bf(w * gs[k0 + kh + kk]) << 16); ba += w * bs[k0 + kh + kk]; }
        atomicAdd(cs + n0 + nn, ca); atomicAdd(bw + n0 + nn, ba);
#pragma unroll
        for (int j = 0; j < 8; ++j) gsc[j] = gs[k0 + 8 * c + j];
    }
#pragma unroll
    for (int j = 0; j < 4; ++j) { const int n = (lane >> 3) + 8 * j; const LAS float* sp = scr + (8 * c) * 33 + n;
        u32x4 o; o.x = pk2(sp[0 * 33] * gsc[0], sp[1 * 33] * gsc[1]); o.y = pk2(sp[2 * 33] * gsc[2], sp[3 * 33] * gsc[3]); o.z = pk2(sp[4 * 33] * gsc[4], sp[5 * 33] * gsc[5]); o.w = pk2(sp[6 * 33] * gsc[6], sp[7 * 33] * gsc[7]);
        *(u32x4*)(WT + (size_t)(n0 + n) * K + k0 + 8 * c) = o; }
    asm volatile("s_waitcnt lgkmcnt(0)" ::: "memory");
}

#define XB_TMO      128
#define XB_XCNT(j)  (256  + 64 * (j))
#define XB_XSUB(j)  (1280 + 64 * (j))
#define XB_XGEN(j)  (2304 + 64 * (j))
#define XB_TOP      3328
#define XB_TOPGEN   3392
#define XCD_BAR_WORDS 3456
#define XB_SPIN_CAP (1u << 22)
__device__ __forceinline__ unsigned xb_ld(unsigned* p)              { return __hip_atomic_load(p, __ATOMIC_RELAXED, __HIP_MEMORY_SCOPE_AGENT); }
__device__ __forceinline__ unsigned xb_add(unsigned* p, unsigned v) { return __hip_atomic_fetch_add(p, v, __ATOMIC_RELAXED, __HIP_MEMORY_SCOPE_AGENT); }
__device__ __forceinline__ unsigned xb_xcc_id() { return (unsigned)__builtin_amdgcn_s_getreg((3 << 11) | 20) & 0xFu; }
#define XB_SPIN(cond, bar) do { unsigned _sp = 0; while (cond) { __builtin_amdgcn_s_sleep(1); \
    if ((++_sp & 255u) == 0u) { if (xb_ld(&(bar)[XB_TMO])) break; if (_sp > XB_SPIN_CAP) { atomicAdd(&(bar)[XB_TMO], 1u); break; } } } } while (0)
struct XcdBarrier { unsigned* bar; unsigned x; volatile LAS unsigned* st; };
__device__ __forceinline__ XcdBarrier xcd_barrier_post(unsigned* bar, volatile LAS unsigned* st) {
    XcdBarrier b; b.bar = bar; b.x = xb_xcc_id(); b.st = st;
    if (threadIdx.x == 0) (void)xb_add(&bar[XB_XCNT(b.x)], 1u);
    return b;
}
__device__ __forceinline__ void xcd_barrier_complete(unsigned* bar, unsigned x, unsigned& nloc, unsigned& nx) {
    const unsigned G = gridDim.x * gridDim.y * gridDim.z;
    unsigned sum, cnt, mine, sp = 0u;
    for (;;) {
        sum = 0u; cnt = 0u; mine = 0u;
#pragma unroll
        for (unsigned j = 0; j < 16; ++j) { const unsigned c = xb_ld(&bar[XB_XCNT(j)]); sum += c; cnt += (c > 0u) ? 1u : 0u; mine = (j == x) ? c : mine; }
        if (sum == G) break;
        __builtin_amdgcn_s_sleep(1);
        if ((++sp & 255u) == 0u) { if (xb_ld(&bar[XB_TMO])) break; if (sp > XB_SPIN_CAP) { atomicAdd(&bar[XB_TMO], 1u); break; } }
    }
    nloc = mine > 0u ? mine : 1u; nx = cnt > 0u ? cnt : 1u;
}
__device__ __forceinline__ void xcd_barrier(const XcdBarrier& b) {
    asm volatile("s_waitcnt vmcnt(0)" ::: "memory");
    __syncthreads();
    if (threadIdx.x == 0) {
        unsigned* bar = b.bar;
        __builtin_amdgcn_s_waitcnt(0);
        unsigned nloc = b.st[0], nx = b.st[1];
        if (nloc == 0u) { xcd_barrier_complete(bar, b.x, nloc, nx); b.st[0] = nloc; b.st[1] = nx; }
        const unsigned old = xb_add(&bar[XB_XSUB(b.x)], 1u);
        const unsigned gen = old / nloc;
        if (old + 1u == (gen + 1u) * nloc) {
            __builtin_amdgcn_fence(__ATOMIC_RELEASE, "agent");
            asm volatile("s_waitcnt vmcnt(0)" ::: "memory");
            const unsigned og = xb_add(&bar[XB_TOP], 1u);
            const unsigned tg = og / nx;
            if (og + 1u == (tg + 1u) * nx) xb_add(&bar[XB_TOPGEN], 1u);
            else XB_SPIN(xb_ld(&bar[XB_TOPGEN]) == tg, bar);
            __builtin_amdgcn_fence(__ATOMIC_ACQUIRE, "agent");
            xb_add(&bar[XB_XGEN(b.x)], 1u);
            asm volatile("s_waitcnt vmcnt(0)" ::: "memory");
        } else {
            XB_SPIN(xb_ld(&bar[XB_XGEN(b.x)]) == gen, bar);
            __builtin_amdgcn_fence(__ATOMIC_ACQUIRE, "agent");
            asm volatile("s_waitcnt vmcnt(0)" ::: "memory");
        }
    }
    __syncthreads();
}

struct Args { const float* in[19]; float* out; unsigned char* ws; int ph_lo, ph_hi; };

struct MixP {
    const bf16_t* P;
    bf16_t* YS;
    int L;
    const float *conv_a, *ln_v_g, *ln_v_b, *b_s, *pool_scale, *conv_d, *conv_d_b, *ln_d_g, *ln_d_b;
    const bf16_t *WsB, *WpoolT, *WpwT;
};

__device__ __forceinline__ void mix_unit(const MixP& mp, LAS unsigned char* lds, int r0, int tid, int lane, int wave) {
    const bf16_t* P = mp.P; const int L = mp.L;
    const int fr = lane & 15, fq = lane >> 4;
    LAS float* HH = (LAS float*)lds;
    LAS bf16_t* AM = (LAS bf16_t*)(lds + R1_OFF);
    LAS float* CV = (LAS float*)(lds + R1_OFF);
    LAS bf16_t* AMD = (LAS bf16_t*)lds;
    LAS bf16_t* VN = (LAS bf16_t*)(lds + VN_OFF);
    const int seq0 = r0 & ~(L - 1);
#pragma unroll 1
    for (int it0 = tid; it0 < 64 * 32; it0 += 2 * NTHR) {
        u32x4 ld[2][8];
#pragma unroll
        for (int q = 0; q < 2; ++q) { const int it = it0 + q * NTHR, tok = it >> 5, oc = it & 31, r = r0 + tok, pos = r - seq0;
            const bf16_t* rp = P + (size_t)r * NC + oc * 8;
            const int dm = pos > 0 ? -NC : 0, dp = pos < L - 1 ? NC : 0;
            ld[q][0] = *(const u32x4*)(rp); ld[q][1] = *(const u32x4*)(rp + 256); ld[q][2] = *(const u32x4*)(rp + 512); ld[q][3] = *(const u32x4*)(rp + 768);
            ld[q][4] = *(const u32x4*)(rp + dm); ld[q][5] = *(const u32x4*)(rp + dm + 512); ld[q][6] = *(const u32x4*)(rp + dp); ld[q][7] = *(const u32x4*)(rp + dp + 512); }
#pragma unroll
        for (int q = 0; q < 2; ++q) { const int it = it0 + q * NTHR, tok = it >> 5, oc = it & 31, r = r0 + tok, pos = r - seq0;
            const float fm = pos > 0 ? 1.f : 0.f, fp = pos < L - 1 ? 1.f : 0.f;
            const float* wa = mp.conv_a + oc * 8;
            const f32x4 w0a = *(const f32x4*)(wa), w0b = *(const f32x4*)(wa + 4), w1a = *(const f32x4*)(wa + 256), w1b = *(const f32x4*)(wa + 260), w2a = *(const f32x4*)(wa + 512), w2b = *(const f32x4*)(wa + 516);
            const float w0[8] = {w0a[0] * fm, w0a[1] * fm, w0a[2] * fm, w0a[3] * fm, w0b[0] * fm, w0b[1] * fm, w0b[2] * fm, w0b[3] * fm};
            const float w1[8] = {w1a[0], w1a[1], w1a[2], w1a[3], w1b[0], w1b[1], w1b[2], w1b[3]};
            const float w2[8] = {w2a[0] * fp, w2a[1] * fp, w2a[2] * fp, w2a[3] * fp, w2b[0] * fp, w2b[1] * fp, w2b[2] * fp, w2b[3] * fp};
            UNPACK8(ld[q][0], h); UNPACK8(ld[q][1], bg); UNPACK8(ld[q][2], cgv); UNPACK8(ld[q][3], z); UNPACK8(ld[q][4], hmf); UNPACK8(ld[q][5], cmf); UNPACK8(ld[q][6], hpf); UNPACK8(ld[q][7], cpf);
            float y[8];
#pragma unroll
            for (int e = 0; e < 8; ++e) { const float cv = w0[e] * (cmf[e] * hmf[e]) + w1[e] * (cgv[e] * h[e]) + w2[e] * (cpf[e] * hpf[e]); y[e] = bg[e] * cv * silu(z[e]); }
            u32x4 o; o.x = pk2(y[0], y[1]); o.y = pk2(y[2], y[3]); o.z = pk2(y[4], y[5]); o.w = pk2(y[6], y[7]);
            *(u32x4*)(mp.YS + (size_t)r * D + oc * 8) = o; }
    }
    {
        const int tok = tid >> 3, o8 = tid & 7, r = r0 + tok, pos = r - seq0;
        const bf16_t* cb = P + (size_t)seq0 * NC + 7 * 256 + o8 * 8;
#define POOL_OUT(GI, WV, BASE, CT) do { const int half_ = 1 << (GI), lo_ = max(pos - half_, 0), hi_ = min(pos + half_, L), cnt_ = hi_ - lo_; \
            float s_[8] = {0.f, 0.f, 0.f, 0.f, 0.f, 0.f, 0.f, 0.f}; \
            _Pragma("unroll") for (int jj = 0; jj < 2 * half_; ++jj) { const float m_ = jj < cnt_ ? 1.f : 0.f; UNPACK8(WV[(BASE) + jj], f_); _Pragma("unroll") for (int e = 0; e < 8; ++e) s_[e] += m_ * f_[e]; } \
            UNPACK8(CT, c_); const float inv_ = 1.0f / (float)cnt_; \
            u32x4 o_; o_.x = pk2(s_[0] * inv_ - c_[0], s_[1] * inv_ - c_[1]); o_.y = pk2(s_[2] * inv_ - c_[2], s_[3] * inv_ - c_[3]); o_.z = pk2(s_[4] * inv_ - c_[4], s_[5] * inv_ - c_[5]); o_.w = pk2(s_[6] * inv_ - c_[6], s_[7] * inv_ - c_[7]); \
            *(LAS u32x4*)(AM + tok * AROW + (GI) * 64 + o8 * 8) = o_; } while (0)
#define POOL_LOAD(GI, WV, BASE, CT) do { const int half_ = 1 << (GI), lo_ = max(pos - half_, 0), hi_ = min(pos + half_, L); \
            _Pragma("unroll") for (int jj = 0; jj < 2 * half_; ++jj) WV[(BASE) + jj] = *(const u32x4*)(cb + (GI) * 64 + (size_t)min(lo_ + jj, hi_ - 1) * NC); \
            CT = *(const u32x4*)(cb + (GI) * 64 + (size_t)pos * NC); } while (0)
        {
            u32x4 wa[14], c0, c1, c2;
            POOL_LOAD(0, wa, 0, c0); POOL_LOAD(1, wa, 2, c1); POOL_LOAD(2, wa, 6, c2);
            POOL_OUT(0, wa, 0, c0); POOL_OUT(1, wa, 2, c1); POOL_OUT(2, wa, 6, c2);
        }
        {
            u32x4 wb[16], c3;
            POOL_LOAD(3, wb, 0, c3);
            POOL_OUT(3, wb, 0, c3);
        }
#undef POOL_OUT
#undef POOL_LOAD
    }
#pragma unroll 1
    for (int it0 = tid; it0 < 94 * 32; it0 += 3 * NTHR) {
        u32x4 la[3], lg[3];
#pragma unroll
        for (int q = 0; q < 3; ++q) { const int it = it0 + q * NTHR, j = it >> 5, oc = it & 31, r = r0 - 15 + j; const bool ok = it < 94 * 32 && r >= seq0 && r < seq0 + L;
            const bf16_t* rp = P + (size_t)(ok ? r : r0) * NC + 9 * 256 + oc * 8;
            la[q] = *(const u32x4*)(rp); lg[q] = *(const u32x4*)(rp + 256); }
#pragma unroll
        for (int q = 0; q < 3; ++q) { const int it = it0 + q * NTHR, j = it >> 5, oc = it & 31, r = r0 - 15 + j; const bool ok = r >= seq0 && r < seq0 + L;
            if (it < 94 * 32) {
                const float mk = ok ? 1.f : 0.f; UNPACK8(la[q], a); UNPACK8(lg[q], gg);
                const f32x4 o0 = (f32x4){mk * a[0] * sigm(gg[0]), mk * a[1] * sigm(gg[1]), mk * a[2] * sigm(gg[2]), mk * a[3] * sigm(gg[3])};
                const f32x4 o1 = (f32x4){mk * a[4] * sigm(gg[4]), mk * a[5] * sigm(gg[5]), mk * a[6] * sigm(gg[6]), mk * a[7] * sigm(gg[7])};
                *(LAS f32x4*)(HH + j * 256 + oc * 8) = o0; *(LAS f32x4*)(HH + j * 256 + oc * 8 + 4) = o1; } }
    }
    __syncthreads();
    {
        const int gi = wave >> 1;
        f32x4 acc[4][2];
#pragma unroll
        for (int rb = 0; rb < 4; ++rb) { acc[rb][0] = (f32x4){0.f, 0.f, 0.f, 0.f}; acc[rb][1] = acc[rb][0]; }
#pragma unroll
        for (int ks = 0; ks < 2; ++ks) {
            bf16x8 bfr[2], afr[4];
#pragma unroll
            for (int cj = 0; cj < 2; ++cj) bfr[cj] = *(const bf16x8*)(mp.WpoolT + (size_t)(gi * 64 + ((32 * wave + 16 * cj) & 63) + fr) * 64 + ks * 32 + fq * 8);
#pragma unroll
            for (int rb = 0; rb < 4; ++rb) afr[rb] = *(const LAS bf16x8*)(AM + (rb * 16 + fr) * AROW + gi * 64 + ks * 32 + fq * 8);
#pragma unroll
            for (int rb = 0; rb < 4; ++rb)
#pragma unroll
                for (int cj = 0; cj < 2; ++cj) acc[rb][cj] = MFMA16(bfr[cj], afr[rb], acc[rb][cj]);
        }
#pragma unroll
        for (int rb = 0; rb < 4; ++rb)
#pragma unroll
            for (int cj = 0; cj < 2; ++cj) { const int r = r0 + rb * 16 + fr, col = 32 * wave + 16 * cj + 4 * fq;
                const u32x2 vz = *(const u32x2*)(P + (size_t)r * NC + 8 * 256 + col); const f32x4 sc = *(const f32x4*)(mp.pool_scale + col);
                const float z0 = bflo(vz.x), z1 = bfhi(vz.x), z2 = bflo(vz.y), z3 = bfhi(vz.y);
                u32x2 o; o.x = pk2(acc[rb][cj][0] * sc[0] * silu(z0), acc[rb][cj][1] * sc[1] * silu(z1)); o.y = pk2(acc[rb][cj][2] * sc[2] * silu(z2), acc[rb][cj][3] * sc[3] * silu(z3));
                *(u32x2*)(mp.YS + (size_t)r * D + 512 + col) = o; }
    }
    __syncthreads();
    {
        const int c = tid & 255, hf = tid >> 8;
        float w[31];
#pragma unroll
        for (int k = 0; k < 31; ++k) w[k] = mp.conv_d[k * 256 + c];
        const float bias = mp.conv_d_b[c];
#pragma unroll 1
        for (int g4 = 0; g4 < 4; ++g4) {
            float win[38];
#pragma unroll
            for (int i = 0; i < 38; ++i) win[i] = HH[(hf * 32 + g4 * 8 + i) * 256 + c];
#pragma unroll
            for (int o = 0; o < 8; ++o) { float a = bias;
#pragma unroll
                for (int k = 0; k < 31; ++k) a += w[k] * win[o + k];
                CV[(hf * 32 + g4 * 8 + o) * 256 + c] = a; }
            asm volatile("" ::: "memory");
        }
    }
    __syncthreads();
    {
        const int t4 = lane >> 4, pp = lane & 15;
        f32x4 gv[4], bv[4];
#pragma unroll
        for (int j = 0; j < 4; ++j) { gv[j] = *(const f32x4*)(mp.ln_d_g + 4 * pp + 64 * j); bv[j] = *(const f32x4*)(mp.ln_d_b + 4 * pp + 64 * j); }
#pragma unroll
        for (int it = 0; it < 2; ++it) { const int tok = wave * 8 + it * 4 + t4;
            f32x4 v[4]; float sm = 0.f;
#pragma unroll
            for (int j = 0; j < 4; ++j) { v[j] = *(const LAS f32x4*)(CV + tok * 256 + 4 * pp + 64 * j); sm += (v[j][0] + v[j][1]) + (v[j][2] + v[j][3]); }
            const float mean = red16(sm) * (1.f / 256.f); float sq = 0.f;
#pragma unroll
            for (int j = 0; j < 4; ++j) { v[j] = v[j] - mean; sq += (v[j][0] * v[j][0] + v[j][1] * v[j][1]) + (v[j][2] * v[j][2] + v[j][3] * v[j][3]); }
            const float rstd = 1.0f / sqrtf(red16(sq) * (1.f / 256.f) + LN_EPS);
#pragma unroll
            for (int j = 0; j < 4; ++j) { const f32x4 y = v[j] * rstd * gv[j] + bv[j];
                u32x2 o; o.x = pk2(silu(y[0]), silu(y[1])); o.y = pk2(silu(y[2]), silu(y[3]));
                *(LAS u32x2*)(AMD + tok * AROW + 4 * pp + 64 * j) = o; } }
    }
    __syncthreads();
    {
        f32x4 acc[4][2];
#pragma unroll
        for (int rb = 0; rb < 4; ++rb) { acc[rb][0] = (f32x4){0.f, 0.f, 0.f, 0.f}; acc[rb][1] = acc[rb][0]; }
#pragma unroll
        for (int ks = 0; ks < 8; ++ks) {
            bf16x8 bfr[2], afr[4];
#pragma unroll
            for (int cj = 0; cj < 2; ++cj) bfr[cj] = *(const bf16x8*)(mp.WpwT + (size_t)(32 * wave + 16 * cj + fr) * 256 + ks * 32 + fq * 8);
#pragma unroll
            for (int rb = 0; rb < 4; ++rb) afr[rb] = *(const LAS bf16x8*)(AMD + (rb * 16 + fr) * AROW + ks * 32 + fq * 8);
#pragma unroll
            for (int rb = 0; rb < 4; ++rb)
#pragma unroll
                for (int cj = 0; cj < 2; ++cj) acc[rb][cj] = MFMA16(bfr[cj], afr[rb], acc[rb][cj]);
        }
#pragma unroll
        for (int rb = 0; rb < 4; ++rb)
#pragma unroll
            for (int cj = 0; cj < 2; ++cj) { const int r = r0 + rb * 16 + fr, col = 32 * wave + 16 * cj + 4 * fq;
                const u32x2 vz = *(const u32x2*)(P + (size_t)r * NC + 11 * 256 + col);
                const float z0 = bflo(vz.x), z1 = bfhi(vz.x), z2 = bflo(vz.y), z3 = bfhi(vz.y);
                u32x2 o; o.x = pk2(acc[rb][cj][0] * silu(z0), acc[rb][cj][1] * silu(z1)); o.y = pk2(acc[rb][cj][2] * silu(z2), acc[rb][cj][3] * silu(z3));
                *(u32x2*)(mp.YS + (size_t)r * D + 768 + col) = o; }
    }
    const int rc = r0 & ~127, p0 = r0 & 127;
    {
        const int t4 = lane >> 4, pp = lane & 15;
        u32x2 vpre[4][4];
#pragma unroll
        for (int it = 0; it < 4; ++it)
#pragma unroll
            for (int j = 0; j < 4; ++j) vpre[it][j] = *(const u32x2*)(P + (size_t)(rc + wave * 16 + it * 4 + t4) * NC + 5 * 256 + 4 * pp + 64 * j);
        f32x4 gv[4], bv[4];
#pragma unroll
        for (int j = 0; j < 4; ++j) { gv[j] = *(const f32x4*)(mp.ln_v_g + 4 * pp + 64 * j); bv[j] = *(const f32x4*)(mp.ln_v_b + 4 * pp + 64 * j); }
#pragma unroll
        for (int it = 0; it < 4; ++it) { const int q = wave * 16 + it * 4 + t4;
            f32x4 v[4]; float sm = 0.f;
#pragma unroll
            for (int j = 0; j < 4; ++j) { const u32x2 vv = vpre[it][j]; v[j] = (f32x4){bflo(vv.x), bfhi(vv.x), bflo(vv.y), bfhi(vv.y)}; sm += (v[j][0] + v[j][1]) + (v[j][2] + v[j][3]); }
            const float mean = red16(sm) * (1.f / 256.f); float sq = 0.f;
#pragma unroll
            for (int j = 0; j < 4; ++j) { v[j] = v[j] - mean; sq += (v[j][0] * v[j][0] + v[j][1] * v[j][1]) + (v[j][2] * v[j][2] + v[j][3] * v[j][3]); }
            const float rstd = 1.0f / sqrtf(red16(sq) * (1.f / 256.f) + LN_EPS);
#pragma unroll
            for (int j = 0; j < 4; ++j) { const f32x4 y = v[j] * rstd * gv[j] + bv[j];
                u32x2 o; o.x = pk2(y[0], y[1]); o.y = pk2(y[2], y[3]);
                *(LAS u32x2*)(VN + q * VROW + 4 * pp + 64 * j) = o; } }
    }
    __syncthreads();
    {
        const int h = wave >> 1;
        f32x4 acc[4][2];
#pragma unroll
        for (int rb = 0; rb < 4; ++rb) { acc[rb][0] = (f32x4){0.f, 0.f, 0.f, 0.f}; acc[rb][1] = acc[rb][0]; }
#pragma unroll
        for (int ks = 0; ks < 4; ++ks) {
            bf16x8 xfr[2], yfr[4];
#pragma unroll
            for (int cj = 0; cj < 2; ++cj) { const LAS bf16_t* vp = VN + (ks * 32 + fq * 8) * VROW + 32 * wave + 16 * cj + fr;
#pragma unroll
                for (int jj = 0; jj < 8; ++jj) xfr[cj][jj] = (short)vp[jj * VROW]; }
#pragma unroll
            for (int rb = 0; rb < 4; ++rb) yfr[rb] = *(const bf16x8*)(mp.WsB + (size_t)(h * 128 + p0 + rb * 16 + fr) * 128 + ks * 32 + fq * 8);
#pragma unroll
            for (int rb = 0; rb < 4; ++rb)
#pragma unroll
                for (int cj = 0; cj < 2; ++cj) acc[rb][cj] = MFMA16(xfr[cj], yfr[rb], acc[rb][cj]);
        }
#pragma unroll
        for (int rb = 0; rb < 4; ++rb) { const int p = p0 + rb * 16 + fr, r = rc + p; const float bias = mp.b_s[h * 128 + p];
#pragma unroll
            for (int cj = 0; cj < 2; ++cj) { const int col = 32 * wave + 16 * cj + 4 * fq;
                const u32x2 vu = *(const u32x2*)(P + (size_t)r * NC + 4 * 256 + col), vz = *(const u32x2*)(P + (size_t)r * NC + 6 * 256 + col);
                const float u0 = bflo(vu.x), u1 = bfhi(vu.x), u2 = bflo(vu.y), u3 = bfhi(vu.y), z0 = bflo(vz.x), z1 = bfhi(vz.x), z2 = bflo(vz.y), z3 = bfhi(vz.y);
                u32x2 o; o.x = pk2(u0 * (acc[rb][cj][0] + bias) * silu(z0), u1 * (acc[rb][cj][1] + bias) * silu(z1));
                o.y = pk2(u2 * (acc[rb][cj][2] + bias) * silu(z2), u3 * (acc[rb][cj][3] + bias) * silu(z3));
                *(u32x2*)(mp.YS + (size_t)r * D + 256 + col) = o; } }
    }
    __syncthreads();
}

__device__ __forceinline__ void final_ln(float* out, const float* stats, const float* lg, const float* lb, int vcu, int G, int tid) {
    const size_t n4 = (size_t)TS * 256, gt = (size_t)vcu * NTHR + tid, NGT = (size_t)G * NTHR;
    f32x4* o4 = (f32x4*)out;
#pragma unroll 1
    for (size_t i0 = gt; i0 < n4; i0 += 8 * NGT) {
        f32x4 v[8];
#pragma unroll
        for (int q = 0; q < 8; ++q) { const size_t i = i0 + q * NGT; v[q] = o4[i < n4 ? i : i0]; }
#pragma unroll
        for (int q = 0; q < 8; ++q) { const size_t i = i0 + q * NGT;
            if (i < n4) { const size_t row = i >> 8; const int c4 = (int)(i & 255);
                const float sm = stats[2 * row], sq = stats[2 * row + 1];
                const float mu = sm * (1.f / 1024.f), rstd = 1.0f / sqrtf(fmaxf(sq * (1.f / 1024.f) - mu * mu, 0.f) + LN_EPS);
                o4[i] = (v[q] - mu) * rstd * ((const f32x4*)lg)[c4] + ((const f32x4*)lb)[c4]; } }
    }
}

__global__ void __launch_bounds__(NTHR, 2) fwd_megakernel(Args args_unused) {
    extern __shared__ __attribute__((aligned(16))) unsigned char lds_raw[];
    LAS unsigned char* lds = (LAS unsigned char*)lds_raw;
    cg::grid_group grid = cg::this_grid();
    const int G = gridDim.x, bx = blockIdx.x;
    const int vcu = (G % 8 == 0) ? (bx % 8) * (G / 8) + bx / 8 : bx;
    typedef const __attribute__((address_space(4))) Args* KArgs;
#define PH_TID int tid = threadIdx.x; asm volatile("" : "+v"(tid)); const int lane = tid & 63, wave = __builtin_amdgcn_readfirstlane(tid >> 6); (void)lane; (void)wave; \
    KArgs ka = (KArgs)__builtin_amdgcn_kernarg_segment_ptr(); asm volatile("" : "+s"(ka)); \
    unsigned char* ws = ka->ws; \
    bf16_t* WinT = (bf16_t*)(ws + WS_WIN); bf16_t* WbrT = (bf16_t*)(ws + WS_WBR); bf16_t* WoutT = (bf16_t*)(ws + WS_WOUT); \
    bf16_t* WpwT = (bf16_t*)(ws + WS_WPW); bf16_t* WpoolT = (bf16_t*)(ws + WS_WPOOL); bf16_t* WsB = (bf16_t*)(ws + WS_WS); \
    bf16_t* XB = (bf16_t*)(ws + WS_XB); bf16_t* XB1 = (bf16_t*)(ws + WS_XB1); bf16_t* PROJ = (bf16_t*)(ws + WS_PROJ); \
    bf16_t* YS = (bf16_t*)(ws + WS_YS); bf16_t* MRG = (bf16_t*)(ws + WS_MRG); float* PRE = (float*)(ws + WS_PRE); \
    float* CS = (float*)(ws + WS_CSBW); float* BW = CS + NC; float* STATS = (float*)(ws + WS_STATS); \
    (void)WinT; (void)WbrT; (void)WoutT; (void)WpwT; (void)WpoolT; (void)WsB; (void)XB; (void)XB1; (void)PROJ; (void)YS; (void)MRG; (void)PRE; (void)CS; (void)BW; (void)STATS
#define SB_VARS const size_t row0 = (size_t)sb * TS; const bool prompt = row0 < (size_t)NPROMPT; \
    const float* xin = prompt ? ka->in[0] + row0 * D : ka->in[1] + (row0 - NPROMPT) * D; float* outp = ka->out + row0 * D; const int L = prompt ? 4096 : 16384; \
    float* st0 = STATS + 2 * row0; float* st1 = STATS + 2 * (size_t)TALL + 2 * row0; (void)xin; (void)outp; (void)L; (void)st0; (void)st1
    const int lo = args_unused.ph_lo, hi = args_unused.ph_hi;
    int ph = 0;
    if (threadIdx.x < 16) ((LAS unsigned*)(lds + XB_LDS_OFF))[threadIdx.x] = 0u;
    __syncthreads();
    const XcdBarrier xbar = xcd_barrier_post((unsigned*)args_unused.ws, (volatile LAS unsigned*)(lds + XB_LDS_OFF));
#define PH_IN (ph >= lo && ph < hi)
#define PH_END do { ++ph; if (ph > lo && ph < hi) { if (hi < 0) grid.sync(); else { for (int rb_ = 0; rb_ < REP_BAR; ++rb_) xcd_barrier(xbar); } } } while (0)

    if (PH_IN) {
        PH_TID;
        LAS float* scr = (LAS float*)(lds + wave * 16384);
        const int gw = vcu * NWAVES + wave, NGW = G * NWAVES;
        constexpr int I_IN = (D / 64) * (NC / 32), I_SQ = (D / 64) * (D / 32), I_PW = (256 / 64) * (256 / 32), I_PL = 2;
        constexpr int PER_L = I_IN + 2 * I_SQ + I_PW + 4 * I_PL, NITEMS = DEPTH * PER_L;
        for (int it = gw; it < NITEMS; it += NGW) {
            const int l = it / PER_L; int r = it % PER_L;
            if (r < I_IN) { transpose_item(ka->in[2] + (size_t)l * D * NC, D, NC, WinT + (size_t)l * NC * D, scr, r, lane, l == 1 ? ka->in[17] : nullptr, ka->in[18], CS, BW, true); continue; } r -= I_IN;
            if (r < I_SQ) { transpose_item(ka->in[15] + (size_t)l * D * D, D, D, WbrT + (size_t)l * D * D, scr, r, lane, nullptr, nullptr, nullptr, nullptr, false); continue; } r -= I_SQ;
            if (r < I_SQ) { transpose_item(ka->in[16] + (size_t)l * D * D, D, D, WoutT + (size_t)l * D * D, scr, r, lane, nullptr, nullptr, nullptr, nullptr, false); continue; } r -= I_SQ;
            if (r < I_PW) { transpose_item(ka->in[14] + (size_t)l * 65536, 256, 256, WpwT + (size_t)l * 65536, scr, r, lane, nullptr, nullptr, nullptr, nullptr, false); continue; } r -= I_PW;
            { const int gi = r / I_PL; transpose_item(ka->in[8] + (size_t)(l * 4 + gi) * 4096, 64, 64, WpoolT + (size_t)(l * 4 + gi) * 4096, scr, r % I_PL, lane, nullptr, nullptr, nullptr, nullptr, false); }
        }
        const size_t gt = (size_t)vcu * NTHR + tid, NGT = (size_t)G * NTHR;
        for (size_t i = gt; i < (size_t)2 * TALL * 2 / 4; i += NGT) ((f32x4*)STATS)[i] = (f32x4){0.f, 0.f, 0.f, 0.f};
        for (size_t i = gt; i < (size_t)DEPTH * 4 * 128 * 128 / 4; i += NGT) { const f32x4 v = *(const f32x4*)(ka->in[6] + 4 * i); u32x2 o; o.x = pk2(v[0], v[1]); o.y = pk2(v[2], v[3]); *(u32x2*)(WsB + 4 * i) = o; }
        for (size_t i0 = gt; i0 < (size_t)TALL * D / 8; i0 += 8 * NGT) {
            f32x4 a[8], b[8];
#pragma unroll
            for (int q = 0; q < 8; ++q) { const size_t i = i0 + q * NGT, e = 8 * (i < (size_t)TALL * D / 8 ? i : i0);
                const float* src = e < (size_t)NPROMPT * D ? ka->in[0] + e : ka->in[1] + (e - (size_t)NPROMPT * D);
                a[q] = *(const f32x4*)(src); b[q] = *(const f32x4*)(src + 4); }
#pragma unroll
            for (int q = 0; q < 8; ++q) { const size_t i = i0 + q * NGT;
                if (i < (size_t)TALL * D / 8) { u32x4 o; o.x = pk2(a[q][0], a[q][1]); o.y = pk2(a[q][2], a[q][3]); o.z = pk2(b[q][0], b[q][1]); o.w = pk2(b[q][2], b[q][3]);
                    *(u32x4*)(XB + 8 * i) = o; } }
        }
        __syncthreads();
    }
    PH_END;

    for (int sb = 0; sb < NSB; ++sb) {
        for (int l = 0; l < DEPTH; ++l) {
            for (int hf = 0; hf < 2; ++hf) {
                if (PH_IN) {
                    if (hf == 1) {
                        PH_TID; SB_VARS;
                        if (l == 0 && sb > 0) final_ln(outp - (size_t)TS * D, st1 - 2 * (size_t)TS, ka->in[17] + D, ka->in[18] + D, vcu, G, tid);
                        MixP mp;
                        mp.P = PROJ; mp.YS = YS; mp.L = L;
                        mp.conv_a = ka->in[3] + l * 3 * 256; mp.ln_v_g = ka->in[4] + l * 256; mp.ln_v_b = ka->in[5] + l * 256; mp.b_s = ka->in[7] + l * 512;
                        mp.pool_scale = ka->in[9] + l * 256; mp.conv_d = ka->in[10] + l * 31 * 256; mp.conv_d_b = ka->in[11] + l * 256; mp.ln_d_g = ka->in[12] + l * 256; mp.ln_d_b = ka->in[13] + l * 256;
                        mp.WsB = WsB + (size_t)l * 65536; mp.WpoolT = WpoolT + (size_t)l * 16384; mp.WpwT = WpwT + (size_t)l * 65536;
                        for (int rep = 0; rep < REP_MIX; ++rep) for (int u = vcu; u < TS / 64; u += G) mix_unit(mp, lds, u * 64, tid, lane, wave);
                    }
                    PH_TID; SB_VARS;
                    const int cofs = hf == 0 ? 0 : NBRC, ncol = hf == 0 ? NBRC : NC - NBRC;
                    pg8::Gemm g{l == 0 ? XB + row0 * D : XB1, WinT + (size_t)l * NC * D + (size_t)cofs * D};
                    pg8::StaticOrder S; S.init(TS, ncol, G, bx);
                    pg8::RepOrder<pg8::StaticOrder, REP_G1> R; R.S = S; R.n = (S.nwg - bx + G - 1) / G;
#define G1_CALL(FOLD_, SIG_, ST_) do { pg8::EpiStoreBf16<FOLD_, SIG_> E{PROJ + cofs, NC, ST_, CS + cofs, BW + cofs}; \
                        pg8::gemm_phase<pg8::EpiStoreBf16<FOLD_, SIG_>, pg8::RepOrder<pg8::StaticOrder, REP_G1>, true, 1024>(lds, g, R, E, tid); } while (0)
                    if (l == 0) { if (hf == 0) G1_CALL(false, false, nullptr); else G1_CALL(false, true, nullptr); }
                    else { if (hf == 0) G1_CALL(true, false, st0); else G1_CALL(true, true, st0); }
#undef G1_CALL
                }
                PH_END;
            }
            if (PH_IN) {
                PH_TID; SB_VARS;
                pg8::Gemm g{YS, WbrT + (size_t)l * D * D};
                pg8::SubOrder<4> S; S.S.init(TS, D, G, bx);
                pg8::EpiGate E{PROJ + 3072, NC, MRG, D};
                pg8::RepOrder<pg8::SubOrder<4>, REP_BR> R; R.S = S; R.n = 4 * ((S.S.nwg - bx + G - 1) / G);
                pg8::gemm_phase<pg8::EpiGate, pg8::RepOrder<pg8::SubOrder<4>, REP_BR>, true, 256>(lds, g, R, E, tid);
            }
            PH_END;
            if (PH_IN) {
                PH_TID; SB_VARS;
                pg8::Gemm g{MRG, WoutT + (size_t)l * D * D};
                pg8::StaticOrder S; S.init(TS, D, G, bx);
                pg8::RepOrder<pg8::StaticOrder, REP_OUT> R; R.S = S; R.n = (S.nwg - bx + G - 1) / G;
                if (l == 0) { pg8::EpiRes<false> E{xin, nullptr, nullptr, nullptr, PRE, XB1, st0, D, ALPHA};
                    pg8::gemm_phase<pg8::EpiRes<false>, pg8::RepOrder<pg8::StaticOrder, REP_OUT>, true, 1024>(lds, g, R, E, tid); }
                else { pg8::EpiRes<true> E{PRE, st0, ka->in[17], ka->in[18], outp, nullptr, st1, D, ALPHA};
                    pg8::gemm_phase<pg8::EpiRes<true>, pg8::RepOrder<pg8::StaticOrder, REP_OUT>, true, 1024>(lds, g, R, E, tid); }
            }
            if (!(l == DEPTH - 1 && sb + 1 < NSB)) PH_END;
        }
    }
    if (PH_IN) {
        PH_TID;
        final_ln(ka->out + (size_t)(NSB - 1) * TS * D, STATS + 2 * (size_t)TALL + 2 * (size_t)(NSB - 1) * TS, ka->in[17] + D, ka->in[18] + D, vcu, G, tid);
    }
#undef PH_IN
#undef PH_END
}

extern "C" void kernel_launch(void* const* d_in, const int* in_sizes, int n_in, void* d_out, int out_size, void* d_ws, size_t ws_size, hipStream_t stream) {
    static int grid = 0;
    if (grid == 0) {
        if (n_in != 19 || ws_size < WS_END || out_size != TALL * D) { fprintf(stderr, "kernel_launch: unexpected shapes (n_in %d, out %d, ws %zu)\n", n_in, out_size, ws_size); grid = -1; return; }
        int dev = 0, cus = 0, per_cu = 0;
        if (hipGetDevice(&dev) != hipSuccess || hipDeviceGetAttribute(&cus, hipDeviceAttributeMultiprocessorCount, dev) != hipSuccess) { grid = -1; return; }
        if (hipFuncSetAttribute((const void*)fwd_megakernel, hipFuncAttributeMaxDynamicSharedMemorySize, LDS_BYTES) != hipSuccess) { fprintf(stderr, "kernel_launch: hipFuncSetAttribute failed\n"); grid = -1; return; }
        if (hipOccupancyMaxActiveBlocksPerMultiprocessor(&per_cu, (const void*)fwd_megakernel, NTHR, LDS_BYTES) != hipSuccess || per_cu < 1) { fprintf(stderr, "kernel_launch: occupancy query says %d\n", per_cu); per_cu = 1; }
        (void)hipGetLastError();
        grid = cus * per_cu;
    }
    if (grid < 0) return;
    if (hipMemsetAsync(d_ws, 0, CTL_ZERO_BYTES, stream) != hipSuccess) { fprintf(stderr, "kernel_launch: memset failed\n"); return; }
    Args a{};
    for (int i = 0; i < 19; ++i) a.in[i] = (const float*)d_in[i];
    a.out = (float*)d_out; a.ws = (unsigned char*)d_ws; a.ph_lo = 0; a.ph_hi = 1 << 20;
    void* kargs[] = {&a};
    hipError_t e = hipLaunchCooperativeKernel((const void*)fwd_megakernel, dim3(grid), dim3(NTHR), kargs, LDS_BYTES, stream);
    if (e != hipSuccess) fprintf(stderr, "kernel_launch: cooperative launch failed: %s (grid %d)\n", hipGetErrorString(e), grid);
}
```

```cpp
#include <hip/hip_runtime.h>
#include <hip/hip_cooperative_groups.h>
#include <cstdio>
#include <cstdint>
namespace cg = cooperative_groups;

namespace pg8 {
#define PG8_LAS __attribute__((address_space(3)))
typedef unsigned short bf16_t;
typedef short bf16x8 __attribute__((ext_vector_type(8)));
typedef float f32x4 __attribute__((ext_vector_type(4)));
typedef unsigned u32x4 __attribute__((ext_vector_type(4)));
typedef unsigned u32x2 __attribute__((ext_vector_type(2)));
typedef float f32x2 __attribute__((ext_vector_type(2)));
constexpr int BM = 256, BK = 64, HALF = 128, HTB = HALF * BK * 2, STAGE_BYTES = 8 * HTB, NXCD = 8, WGM = 8;

__host__ __device__ __forceinline__ int lds_byte(int r, int c) { const int st = (r >> 4) * 2 + (c >> 5), rr = r & 15, cc = c & 31, ob = rr * 64 + cc * 2; return st * 1024 + (ob ^ (((ob >> 9) & 1) << 5)); }
__host__ __device__ __forceinline__ void stage_rc(int b, int& R, int& C) { const int st = b / 1024, sb = b % 1024, swz = sb ^ (((sb >> 9) & 1) << 5); R = (st >> 1) * 16 + swz / 64; C = (st & 1) * 32 + (swz % 64) / 2; }
__host__ __device__ __forceinline__ int perm32(int rho) { const int n = rho >> 4, i = rho & 15; return 8 * (i >> 2) + 4 * n + (i & 3); }

struct Unit { int pm, pn, kb; };
struct Gemm { const bf16_t* A; const bf16_t* Bt; };

struct StaticOrder {
    int nM, nN, nwg, G, c;
    __host__ __device__ void init(int M, int N, int G_, int c_) { nM = M / BM; nN = N / BM; nwg = nM * nN; G = G_; c = c_; }
    __host__ __device__ bool next(int i, Unit& u) const {
        const long L = (long)i * G + c; if (L >= nwg) return false;
        u.kb = 0;
        if (((G | nwg | nM) & 7) == 0) {
            const int wgid = (c & 7) * (nwg >> 3) + (c >> 3) + i * (G >> 3), nig = WGM * nN, gid = wgid / nig, rem = wgid - gid * nig;
            u.pm = gid * WGM + (rem & (WGM - 1)); u.pn = rem / WGM; return true;
        }
        int wgid = (int)L; { const int q = nwg / NXCD, r = nwg % NXCD, xcd = wgid % NXCD, off = wgid / NXCD; wgid = (xcd < r ? xcd * (q + 1) : r * (q + 1) + (xcd - r) * q) + off; }
        const int nig = WGM * nN, gid = wgid / nig, fm = gid * WGM, gsz = (nM - fm) < WGM ? (nM - fm) : WGM;
        u.pm = fm + ((wgid % nig) % gsz); u.pn = (wgid % nig) / gsz; return true;
    }
};
template <int NSUB> struct SubOrder {
    StaticOrder S;
    __host__ __device__ bool next(int i, Unit& u) const { if (!S.next(i / NSUB, u)) return false; u.kb = i % NSUB; return true; }
};

template <class Base, int REP> struct RepOrder {
    Base S; int n;
    __host__ __device__ bool next(int i, Unit& u) const { if constexpr (REP == 1) return S.next(i, u); else { if (i >= REP * n) return false; return S.next(i % n, u); } }
};
__device__ __forceinline__ unsigned cvt_pk_bf16(float lo, float hi) { unsigned r; asm volatile("v_cvt_pk_bf16_f32 %0, %1, %2" : "=v"(r) : "v"(lo), "v"(hi)); return r; }
__device__ __forceinline__ float sigm(float x) { return __builtin_amdgcn_rcpf(1.f + __expf(-x)); }
__device__ __forceinline__ float bflo(unsigned w) { return __uint_as_float(w << 16); }
__device__ __forceinline__ float bfhi(unsigned w) { return __uint_as_float(w & 0xffff0000u); }

#define PG8_ZERO_ACC(acc) do { _Pragma("unroll") for (int a_ = 0; a_ < 2; ++a_) _Pragma("unroll") for (int b_ = 0; b_ < 2; ++b_) _Pragma("unroll") for (int m_ = 0; m_ < 4; ++m_) _Pragma("unroll") for (int n_ = 0; n_ < 2; ++n_) acc[a_][b_][m_][n_] = (f32x4){0.f, 0.f, 0.f, 0.f}; } while (0)

template <bool FOLD, bool SIG> struct EpiStoreBf16 {
    static constexpr bool PERM = true;
    bf16_t* O; int ldc;
    const float* stats;
    const float* cs; const float* bw;
    __device__ __forceinline__ void operator()(f32x4 (&acc)[2][2][4][2], const Unit& u, int wr, int wc, int fr, int fq) const {
        const int row0 = u.pm * BM + wr * 64 + fr, col0 = u.pn * BM + wc * 32 + 8 * fq;
        if constexpr (FOLD) {
            float mu[2][4], rs[2][4];
#pragma unroll
            for (int ai = 0; ai < 2; ++ai)
#pragma unroll
                for (int m = 0; m < 4; ++m) { const size_t row = (size_t)(row0 + ai * HALF + m * 16);
                    const float sm = stats[2 * row], sq = stats[2 * row + 1];
                    mu[ai][m] = sm * (1.f / 1024.f); rs[ai][m] = __builtin_amdgcn_rsqf(fmaxf(sq * (1.f / 1024.f) - mu[ai][m] * mu[ai][m], 0.f) + 1e-5f); }
            f32x4 c4[2][2], b4[2][2];
#pragma unroll
            for (int bj = 0; bj < 2; ++bj)
#pragma unroll
                for (int n = 0; n < 2; ++n) { c4[bj][n] = *(const f32x4*)(cs + col0 + bj * HALF + 4 * n); b4[bj][n] = *(const f32x4*)(bw + col0 + bj * HALF + 4 * n); }
#pragma unroll
            for (int bj = 0; bj < 2; ++bj)
#pragma unroll
                for (int n = 0; n < 2; ++n)
#pragma unroll
                    for (int ai = 0; ai < 2; ++ai)
#pragma unroll
                        for (int m = 0; m < 4; ++m) acc[ai][bj][m][n] = (acc[ai][bj][m][n] - c4[bj][n] * mu[ai][m]) * rs[ai][m] + b4[bj][n];
        }
        if constexpr (SIG) {
            char* gt_ = (char*)(O + (size_t)(u.pm * BM) * ldc + u.pn * 64);
            const unsigned gl_ = (unsigned)((wr * 64 + fr) * ldc + wc * 16 + 4 * fq) * 2u;
#pragma unroll
            for (int ai = 0; ai < 2; ++ai)
#pragma unroll
                for (int m = 0; m < 4; ++m) {
                    f32x4 tq[4], sg[4];
#pragma unroll
                    for (int i = 0; i < 4; ++i) { const f32x4 v = acc[ai][i >> 1][m][i & 1];
#pragma unroll
                        for (int e = 0; e < 4; ++e) { tq[i][e] = 1.f + __builtin_amdgcn_exp2f(fmaxf(v[e], -30.f) * -1.4426950408889634f); sg[i][e] = __builtin_amdgcn_rcpf(tq[i][e]); } }
                    char* rowp = gt_ + (size_t)((ai * HALF + m * 16) * ldc) * 2;
#pragma unroll
                    for (int i = 0; i < 4; ++i) { const f32x4 r = i < 3 ? sg[i] * tq[i < 3 ? i + 1 : 3] : sg[3];
                        u32x2 w; w.x = cvt_pk_bf16(r[0], r[1]); w.y = cvt_pk_bf16(r[2], r[3]);
                        *(u32x2*)(rowp + i * 2048 + gl_) = w; }
                }
        } else {
        char* tile = (char*)(O + (size_t)(u.pm * BM) * ldc + u.pn * BM);
        const unsigned lofs = (unsigned)((wr * 64 + fr) * ldc + wc * 32 + 8 * fq) * 2u;
#pragma unroll
        for (int ai = 0; ai < 2; ++ai)
#pragma unroll
            for (int m = 0; m < 4; ++m) { char* rowp = tile + (size_t)((ai * HALF + m * 16) * ldc) * 2;
#pragma unroll
                for (int bj = 0; bj < 2; ++bj) { const f32x4 v0 = acc[ai][bj][m][0], v1 = acc[ai][bj][m][1];
                    u32x4 w; w.x = cvt_pk_bf16(v0[0], v0[1]); w.y = cvt_pk_bf16(v0[2], v0[3]); w.z = cvt_pk_bf16(v1[0], v1[1]); w.w = cvt_pk_bf16(v1[2], v1[3]);
                    *(u32x4*)(rowp + bj * HALF * 2 + lofs) = w; } }
        }
        PG8_ZERO_ACC(acc);
    }
};

struct EpiGate {
    static constexpr bool PERM = true;
    const bf16_t* Gt; int ldg;
    bf16_t* O; int ldc;
    __device__ __forceinline__ void operator()(f32x4 (&acc)[2][2][4][2], const Unit& u, int wr, int wc, int fr, int fq) const {
        const bool last = u.kb == 3;
        const char* gtile = (const char*)(Gt + (size_t)(u.pm * BM) * ldg + u.kb * 1024 + u.pn * BM);
        char* otile = (char*)(O + (size_t)(u.pm * BM) * ldc + u.pn * BM);
        int frl = fr; asm volatile("" : "+v"(frl));
        const unsigned glofs = (unsigned)((wr * 64 + frl) * ldg + wc * 32 + 8 * fq) * 2u, olofs = (unsigned)((wr * 64 + frl) * ldc + wc * 32 + 8 * fq) * 2u;
        const float keep = last ? 0.f : 1.f;
        u32x4 ga[2][4][2];
#pragma unroll
        for (int ai = 0; ai < 2; ++ai)
#pragma unroll
            for (int m = 0; m < 4; ++m)
#pragma unroll
                for (int bj = 0; bj < 2; ++bj) ga[ai][m][bj] = *(const u32x4*)(gtile + (size_t)((ai * HALF + m * 16) * ldg + bj * HALF) * 2 + glofs);
#pragma unroll
        for (int ai = 0; ai < 2; ++ai) {
#pragma unroll
            for (int m = 0; m < 4; ++m)
#pragma unroll
                for (int bj = 0; bj < 2; ++bj) {
                    const u32x4 va = ga[ai][m][bj];
                    f32x4 v0 = acc[ai][bj][m][0], v1 = acc[ai][bj][m][1];
                    v0[0] *= bflo(va.x); v0[1] *= bfhi(va.x); v0[2] *= bflo(va.y); v0[3] *= bfhi(va.y); v1[0] *= bflo(va.z); v1[1] *= bfhi(va.z); v1[2] *= bflo(va.w); v1[3] *= bfhi(va.w);
                    if (last) {
                        u32x4 w; w.x = cvt_pk_bf16(v0[0], v0[1]); w.y = cvt_pk_bf16(v0[2], v0[3]); w.z = cvt_pk_bf16(v1[0], v1[1]); w.w = cvt_pk_bf16(v1[2], v1[3]);
                        *(u32x4*)(otile + (size_t)((ai * HALF + m * 16) * ldc + bj * HALF) * 2 + olofs) = w;
                    }
                    acc[ai][bj][m][0] = v0 * keep; acc[ai][bj][m][1] = v1 * keep;
                }
            asm volatile("" ::: "memory");
        }
    }
};

template <bool L1> struct EpiRes {
    static constexpr bool PERM = false;
    const float* base; const float* bstats; const float* lg; const float* lb;
    float* O; bf16_t* XO; float* ostats; int ldc; float alpha;
    __device__ __forceinline__ void operator()(f32x4 (&acc)[2][2][4][2], const Unit& u, int wr, int wc, int fr, int fq) const {
        const int row0 = u.pm * BM + wr * 64 + fr, col0 = u.pn * BM + wc * 32 + 4 * fq;
        const char* btile = (const char*)(base + (size_t)(u.pm * BM) * ldc + u.pn * BM); char* otile = (char*)(O + (size_t)(u.pm * BM) * ldc + u.pn * BM);
        char* xtile = (char*)(XO + (size_t)(u.pm * BM) * ldc + u.pn * BM);
        const unsigned lofs = (unsigned)((wr * 64 + fr) * ldc + wc * 32 + 4 * fq) * 4u;
        f32x4 g4[2][2], b4[2][2];
        if constexpr (L1) {
#pragma unroll
            for (int bj = 0; bj < 2; ++bj)
#pragma unroll
                for (int n = 0; n < 2; ++n) { g4[bj][n] = *(const f32x4*)(lg + col0 + bj * HALF + n * 16); b4[bj][n] = *(const f32x4*)(lb + col0 + bj * HALF + n * 16); }
        }
        constexpr int NB = L1 ? 2 : 4;
#pragma unroll
        for (int aim = 0; aim < 8 / NB; ++aim) { const int ai = (aim * NB) >> 2, mh = (aim * NB) & 3;
            f32x4 xv[NB][2][2];
#pragma unroll
            for (int mm = 0; mm < NB; ++mm)
#pragma unroll
                for (int bj = 0; bj < 2; ++bj)
#pragma unroll
                    for (int n = 0; n < 2; ++n) xv[mm][bj][n] = *(const f32x4*)(btile + (size_t)((ai * HALF + (mh + mm) * 16) * ldc + bj * HALF + n * 16) * 4 + lofs);
            float mu2[NB], rs2[NB];
#pragma unroll
            for (int mm = 0; mm < NB; ++mm) { mu2[mm] = 0.f; rs2[mm] = 1.f; }
            if constexpr (L1) {
                f32x2 st2[NB];
#pragma unroll
                for (int mm = 0; mm < NB; ++mm) st2[mm] = *(const f32x2*)(bstats + 2 * (size_t)(row0 + ai * HALF + (mh + mm) * 16));
#pragma unroll
                for (int mm = 0; mm < NB; ++mm) { mu2[mm] = st2[mm][0] * (1.f / 1024.f); rs2[mm] = __builtin_amdgcn_rsqf(fmaxf(st2[mm][1] * (1.f / 1024.f) - mu2[mm] * mu2[mm], 0.f) + 1e-5f); }
            }
#pragma unroll
            for (int mm = 0; mm < NB; ++mm) { const int m = mh + mm; const size_t row = (size_t)(row0 + ai * HALF + m * 16); const size_t uo = (size_t)((ai * HALF + m * 16) * ldc);
                f32x4 ps4 = (f32x4){0.f, 0.f, 0.f, 0.f}, pq4 = ps4;
#pragma unroll
                for (int bj = 0; bj < 2; ++bj)
#pragma unroll
                    for (int n = 0; n < 2; ++n) { f32x4 x = xv[mm][bj][n];
                        if constexpr (L1) x = (x - mu2[mm]) * rs2[mm] * g4[bj][n] + b4[bj][n];
                        const f32x4 v = x * alpha + acc[ai][bj][m][n];
                        *(f32x4*)(otile + (uo + bj * HALF + n * 16) * 4 + lofs) = v;
                        if constexpr (!L1) { u32x2 w; w.x = cvt_pk_bf16(v[0], v[1]); w.y = cvt_pk_bf16(v[2], v[3]); *(u32x2*)(xtile + (uo + bj * HALF + n * 16) * 2 + (lofs >> 1)) = w; }
                        ps4 += v; pq4 += v * v; }
                float ps = (ps4[0] + ps4[1]) + (ps4[2] + ps4[3]), pq = (pq4[0] + pq4[1]) + (pq4[2] + pq4[3]);
                ps += __shfl_xor(ps, 16); ps += __shfl_xor(ps, 32); pq += __shfl_xor(pq, 16); pq += __shfl_xor(pq, 32);
                if (fq == 0) { atomicAdd(ostats + 2 * row, ps); atomicAdd(ostats + 2 * row + 1, pq); } }
            asm volatile("" ::: "memory");
        }
        PG8_ZERO_ACC(acc);
    }
};

template <class Epi, class Sched, bool ALIGN_EPI, int KU>
__device__ __forceinline__ void gemm_phase(PG8_LAS unsigned char* lds, const Gemm g, const Sched& S, const Epi& E, const int tid) {
    const int wid = __builtin_amdgcn_readfirstlane(tid >> 6), lane = tid & 63, wr = wid >> 2, wc = wid & 3, fr = lane & 15, fq = lane >> 4;
    constexpr int K = KU, nt = K / BK, LD = 1024;
    unsigned voffA[2], voffB[2];
#pragma unroll
    for (int i = 0; i < 2; ++i) { int R, C; stage_rc(tid * 16 + i * 8192, R, C); const int Rb = Epi::PERM ? ((R & ~31) + perm32(R & 31)) : R;
        voffA[i] = (unsigned)(R * LD + C) * 2u; voffB[i] = (unsigned)(Rb * LD + C) * 2u; }
    constexpr size_t kstep = (size_t)(BK * 2);
    constexpr size_t hstepA = (size_t)HALF * LD * 2, hstepB = hstepA;
    constexpr size_t tstepA = 2 * hstepA, tstepB = 2 * hstepB;
    constexpr size_t ksub = (size_t)K * 2;
    const unsigned ldsw = (unsigned)wid * 1024u;
    const int aoff = lds_byte(wr * 64 + fr, fq * 8), boff = lds_byte(wc * 32 + fr, fq * 8);
#define PG8_SA(b, h) (((b) * 2 + (h)) * HTB)
#define PG8_SB(b, h) ((4 + (b) * 2 + (h)) * HTB)
#define PG8_STAGE(bufoff, gbase, voff) do { _Pragma("unroll") for (int _i = 0; _i < 2; ++_i) \
        __builtin_amdgcn_global_load_lds((const unsigned*)((const char*)(gbase) + (voff)[_i]), (PG8_LAS unsigned*)(lds + (bufoff) + ldsw + _i * 8192), 16, 0, 0); } while (0)
#define PG8_LDA(dst, b, h) do { _Pragma("unroll") for (int m = 0; m < 4; ++m) _Pragma("unroll") for (int k = 0; k < 2; ++k) dst[m][k] = *(const PG8_LAS bf16x8*)(lds + PG8_SA(b, h) + aoff + m * 2048 + k * 1024); } while (0)
#define PG8_LDB(dst, b, h) do { _Pragma("unroll") for (int n = 0; n < 2; ++n) _Pragma("unroll") for (int k = 0; k < 2; ++k) dst[n][k] = *(const PG8_LAS bf16x8*)(lds + PG8_SB(b, h) + boff + n * 2048 + k * 1024); } while (0)
#define PG8_MMA(ai, bj, At, Bt) do { __builtin_amdgcn_s_setprio(1); _Pragma("unroll") for (int m = 0; m < 4; ++m) _Pragma("unroll") for (int n = 0; n < 2; ++n) _Pragma("unroll") for (int k = 0; k < 2; ++k) \
        acc[ai][bj][m][n] = __builtin_amdgcn_mfma_f32_16x16x32_bf16(Bt[n][k], At[m][k], acc[ai][bj][m][n], 0, 0, 0); __builtin_amdgcn_s_setprio(0); } while (0)
#define PG8_WAIT_V(n) asm volatile("s_waitcnt vmcnt(" #n ")" ::: "memory")
#define PG8_WAIT_L(n) asm volatile("s_waitcnt lgkmcnt(" #n ")" ::: "memory")
#define PG8_BAR __builtin_amdgcn_s_barrier()
#define PG8_SCHED __builtin_amdgcn_sched_barrier(0)
    Unit cur, nxt; int ui = 0;
    if (!S.next(0, cur)) return;
    f32x4 acc[2][2][4][2];
    PG8_ZERO_ACC(acc);
    bf16x8 At[4][2], B0[2][2], B1[2][2];
    const char* cA = (const char*)g.A + (size_t)cur.pm * tstepA + (size_t)cur.kb * ksub; const char* cB = (const char*)g.Bt + (size_t)cur.pn * tstepB + (size_t)cur.kb * ksub;
    PG8_STAGE(PG8_SB(0, 0), cB, voffB); PG8_STAGE(PG8_SB(0, 1), cB + hstepB, voffB); PG8_STAGE(PG8_SA(0, 0), cA, voffA); PG8_STAGE(PG8_SA(0, 1), cA + hstepA, voffA);
    if (wr == 1) PG8_BAR;
    PG8_WAIT_V(2); PG8_BAR;
    PG8_STAGE(PG8_SB(1, 0), cB + kstep, voffB); PG8_STAGE(PG8_SA(1, 0), cA + kstep, voffA); PG8_STAGE(PG8_SB(1, 1), cB + hstepB + kstep, voffB);
    PG8_WAIT_V(6); PG8_BAR;
    for (;;) {
        const bool has_next = S.next(ui + 1, nxt);
        const char* nA = has_next ? (const char*)g.A + (size_t)nxt.pm * tstepA + (size_t)nxt.kb * ksub : cA;
        const char* nB = has_next ? (const char*)g.Bt + (size_t)nxt.pn * tstepB + (size_t)nxt.kb * ksub : cB;
        for (int t = 0; t < nt; t += 2) {
            const bool last = (t == nt - 2);
            const char* a1 = cA + (size_t)(t + 1) * kstep;
            const char* a2 = last ? nA : cA + (size_t)(t + 2) * kstep; const char* b2 = last ? nB : cB + (size_t)(t + 2) * kstep;
            const char* a3 = a2 + kstep; const char* b3 = b2 + kstep;
            PG8_LDB(B0, 0, 0); PG8_LDB(B1, 0, 1); PG8_SCHED; PG8_LDA(At, 0, 0); PG8_STAGE(PG8_SA(1, 1), a1 + hstepA, voffA);
            PG8_WAIT_V(8); PG8_WAIT_L(0); PG8_BAR; PG8_MMA(0, 0, At, B0); PG8_MMA(0, 1, At, B1); PG8_BAR; PG8_SCHED;
            PG8_LDA(At, 0, 1); PG8_STAGE(PG8_SB(0, 0), b2, voffB); PG8_STAGE(PG8_SB(0, 1), b2 + hstepB, voffB); PG8_STAGE(PG8_SA(0, 0), a2, voffA);
            PG8_WAIT_V(8); PG8_WAIT_L(0); PG8_BAR; PG8_MMA(1, 0, At, B0); PG8_MMA(1, 1, At, B1); PG8_BAR; PG8_SCHED;
            PG8_LDB(B0, 1, 0); PG8_LDB(B1, 1, 1); PG8_SCHED; PG8_LDA(At, 1, 0); PG8_STAGE(PG8_SA(0, 1), a2 + hstepA, voffA);
            PG8_WAIT_V(8); PG8_WAIT_L(0); PG8_BAR; PG8_MMA(0, 0, At, B0); PG8_MMA(0, 1, At, B1); PG8_BAR; PG8_SCHED;
            PG8_LDA(At, 1, 1); PG8_STAGE(PG8_SB(1, 0), b3, voffB); PG8_STAGE(PG8_SB(1, 1), b3 + hstepB, voffB); PG8_STAGE(PG8_SA(1, 0), a3, voffA);
            PG8_WAIT_V(8); PG8_WAIT_L(0); PG8_BAR; PG8_MMA(1, 0, At, B0); PG8_MMA(1, 1, At, B1); PG8_BAR; PG8_SCHED;
        }
        if constexpr (ALIGN_EPI) { if (wr == 0) PG8_BAR; }
        E(acc, cur, wr, wc, fr, fq);
        if (!has_next) break;
        cur = nxt; cA = nA; cB = nB; ++ui;
        if constexpr (ALIGN_EPI) { if (wr == 1) PG8_BAR; }
    }
    PG8_WAIT_V(0);
    if constexpr (!ALIGN_EPI) { if (wr == 0) PG8_BAR; }
    PG8_BAR;
#undef PG8_SA
#undef PG8_SB
#undef PG8_STAGE
#undef PG8_LDA
#undef PG8_LDB
#undef PG8_MMA
#undef PG8_WAIT_V
#undef PG8_WAIT_L
#undef PG8_BAR
#undef PG8_SCHED
}
}

#ifndef REP_G1
#define REP_G1 1
#endif
#ifndef REP_MIX
#define REP_MIX 1
#endif
#ifndef REP_BR
#define REP_BR 1
#endif
#ifndef REP_OUT
#define REP_OUT 1
#endif
#ifndef REP_BAR
#define REP_BAR 1
#endif
#ifndef REP_LN
#define REP_LN 1
#endif
using pg8::bf16_t; using pg8::bf16x8; using pg8::f32x4; using pg8::u32x4; using pg8::u32x2; using pg8::f32x2;
#define LAS __attribute__((address_space(3)))
constexpr int NWAVES = 8, NTHR = 512;
#ifndef TS_ROWS
#define TS_ROWS 16384
#endif
constexpr int D = 1024, NC = 7168, NBRC = 3072, TS = TS_ROWS, TALL = 81920, NSB = TALL / TS, NPROMPT = 65536, DEPTH = 2;
constexpr float LN_EPS = 1e-5f, ALPHA = 1.41421356237309515f;
constexpr size_t MiB = 1u << 20;
constexpr size_t WS_WIN = 1 * MiB, WS_WBR = 29 * MiB, WS_WOUT = 33 * MiB, WS_WPW = 37 * MiB, WS_WPOOL = 38 * MiB, WS_WS = 39 * MiB;
constexpr size_t WS_CSBW = 65536, WS_STATS = 40 * MiB, STATS_BYTES = 2 * MiB;
constexpr size_t WS_XB = 42 * MiB, WS_XB1 = 202 * MiB, WS_PROJ = WS_XB1 + (size_t)TS * D * 2, WS_YS = WS_PROJ + (size_t)TS * NC * 2, WS_MRG = WS_YS + (size_t)TS * D * 2,
                 WS_PRE = WS_MRG + (size_t)TS * D * 2, WS_END = WS_PRE + (size_t)TS * D * 4;
constexpr int LDS_BYTES = 161792 + 64;
constexpr int XB_LDS_OFF = 161792;
constexpr size_t CTL_ZERO_BYTES = 131072;
constexpr int R1_OFF = 96256, VN_OFF = 34816, AROW = 264, VROW = 272;

__device__ __forceinline__ float wave_sum(float v) {
#pragma unroll
    for (int o = 1; o < 64; o <<= 1) v += __shfl_xor(v, o);
    return v;
}
__device__ __forceinline__ float red16(float v) {
    v += __shfl_xor(v, 1); v += __shfl_xor(v, 2); v += __shfl_xor(v, 4); v += __shfl_xor(v, 8); return v;
}
__device__ __forceinline__ unsigned f2bf(float f) { unsigned u = __builtin_bit_cast(unsigned, f); return (u + 0x7fffu + ((u >> 16) & 1u)) >> 16; }
__device__ __forceinline__ unsigned pk2(float lo, float hi) { return f2bf(lo) | (f2bf(hi) << 16); }
__device__ __forceinline__ float sigm(float x) { return __builtin_amdgcn_rcpf(1.f + __expf(-x)); }
__device__ __forceinline__ float silu(float x) { return x * sigm(x); }
__device__ __forceinline__ float bflo(unsigned w) { return __uint_as_float(w << 16); }
__device__ __forceinline__ float bfhi(unsigned w) { return __uint_as_float(w & 0xffff0000u); }
#define UNPACK8(v, f) float f[8] = {bflo((v).x), bfhi((v).x), bflo((v).y), bfhi((v).y), bflo((v).z), bfhi((v).z), bflo((v).w), bfhi((v).w)}
#define MFMA16(x, y, c) __builtin_amdgcn_mfma_f32_16x16x32_bf16((x), (y), (c), 0, 0, 0)

__device__ __forceinline__ int gate_src_col(int nout) {
    const int c = nout - 3072, t = c >> 8, r = c & 255, bj = r >> 7, wc = (r >> 5) & 3, fq = (r >> 3) & 3, n = (r >> 2) & 1, e = r & 3;
    return 3072 + (2 * bj + n) * 1024 + 64 * t + 16 * wc + 4 * fq + e;
}
__device__ __forceinline__ void transpose_item(const float* W, int K, int N, bf16_t* WT, LAS float* scr, int item, int lane, const float* gs, const float* bs, float* cs, float* bw, bool gperm) {
    const int nblk = N / 32, kb = item / nblk, nb = item % nblk, k0 = 64 * kb, n0 = 32 * nb;
    const int scol = (gperm && n0 >= 3072) ? gate_src_col(n0 + (lane & 31)) : n0 + (lane & 31);
#pragma unroll 8
    for (int i = 0; i < 32; ++i) { const int kk = 2 * i + (lane >> 5); scr[kk * 33 + (lane & 31)] = W[(size_t)(k0 + kk) * N + scol]; }
    asm volatile("s_waitcnt lgkmcnt(0)" ::: "memory");
    const int c = lane & 7;
    float gsc[8] = {1.f, 1.f, 1.f, 1.f, 1.f, 1.f, 1.f, 1.f};
    if (gs) {
        float ca = 0.f, ba = 0.f; const int kh = (lane >> 5) * 32, nn = lane & 31;
#pragma unroll 8
        for (int kk = 0; kk < 32; ++kk) { const float w = scr[(kh + kk) * 33 + nn]; ca += __uint_as_float(f2bf(w * gs[k0 + kh + kk]) << 16); ba += w * bs[k0 + kh + kk]; }
        atomicAdd(cs + n0 + nn, ca); atomicAdd(bw + n0 + nn, ba);
#pragma unroll
        for (int j = 0; j < 8; ++j) gsc[j] = gs[k0 + 8 * c + j];
    }
#pragma unroll
    for (int j = 0; j < 4; ++j) { const int n = (lane >> 3) + 8 * j; const LAS float* sp = scr + (8 * c) * 33 + n;
        u32x4 o; o.x = pk2(sp[0 * 33] * gsc[0], sp[1 * 33] * gsc[1]); o.y = pk2(sp[2 * 33] * gsc[2], sp[3 * 33] * gsc[3]); o.z = pk2(sp[4 * 33] * gsc[4], sp[5 * 33] * gsc[5]); o.w = pk2(sp[6 * 33] * gsc[6], sp[7 * 33] * gsc[7]);
        *(u32x4*)(WT + (size_t)(n0 + n) * K + k0 + 8 * c) = o; }
    asm volatile("s_waitcnt lgkmcnt(0)" ::: "memory");
}

#define XB_TMO      128
#define XB_XCNT(j)  (256  + 64 * (j))
#define XB_XSUB(j)  (1280 + 64 * (j))
#define XB_XGEN(j)  (2304 + 64 * (j))
#define XB_TOP      3328
#define XB_TOPGEN   3392
#define XCD_BAR_WORDS 3456
#define XB_SPIN_CAP (1u << 22)
__device__ __forceinline__ unsigned xb_ld(unsigned* p)              { return __hip_atomic_load(p, __ATOMIC_RELAXED, __HIP_MEMORY_SCOPE_AGENT); }
__device__ __forceinline__ unsigned xb_add(unsigned* p, unsigned v) { return __hip_atomic_fetch_add(p, v, __ATOMIC_RELAXED, __HIP_MEMORY_SCOPE_AGENT); }
__device__ __forceinline__ unsigned xb_xcc_id() { return (unsigned)__builtin_amdgcn_s_getreg((3 << 11) | 20) & 0xFu; }
#define XB_SPIN(cond, bar) do { unsigned _sp = 0; while (cond) { __builtin_amdgcn_s_sleep(1); \
    if ((++_sp & 255u) == 0u) { if (xb_ld(&(bar)[XB_TMO])) break; if (_sp > XB_SPIN_CAP) { atomicAdd(&(bar)[XB_TMO], 1u); break; } } } } while (0)
struct XcdBarrier { unsigned* bar; unsigned x; volatile LAS unsigned* st; };
__device__ __forceinline__ XcdBarrier xcd_barrier_post(unsigned* bar, volatile LAS unsigned* st) {
    XcdBarrier b; b.bar = bar; b.x = xb_xcc_id(); b.st = st;
    if (threadIdx.x == 0) (void)xb_add(&bar[XB_XCNT(b.x)], 1u);
    return b;
}
__device__ __forceinline__ void xcd_barrier_complete(unsigned* bar, unsigned x, unsigned& nloc, unsigned& nx) {
    const unsigned G = gridDim.x * gridDim.y * gridDim.z;
    unsigned sum, cnt, mine, sp = 0u;
    for (;;) {
        sum = 0u; cnt = 0u; mine = 0u;
#pragma unroll
        for (unsigned j = 0; j < 16; ++j) { const unsigned c = xb_ld(&bar[XB_XCNT(j)]); sum += c; cnt += (c > 0u) ? 1u : 0u; mine = (j == x) ? c : mine; }
        if (sum == G) break;
        __builtin_amdgcn_s_sleep(1);
        if ((++sp & 255u) == 0u) { if (xb_ld(&bar[XB_TMO])) break; if (sp > XB_SPIN_CAP) { atomicAdd(&bar[XB_TMO], 1u); break; } }
    }
    nloc = mine > 0u ? mine : 1u; nx = cnt > 0u ? cnt : 1u;
}
__device__ __forceinline__ void xcd_barrier(const XcdBarrier& b) {
    asm volatile("s_waitcnt vmcnt(0)" ::: "memory");
    __syncthreads();
    if (threadIdx.x == 0) {
        unsigned* bar = b.bar;
        __builtin_amdgcn_s_waitcnt(0);
        unsigned nloc = b.st[0], nx = b.st[1];
        if (nloc == 0u) { xcd_barrier_complete(bar, b.x, nloc, nx); b.st[0] = nloc; b.st[1] = nx; }
        const unsigned old = xb_add(&bar[XB_XSUB(b.x)], 1u);
        const unsigned gen = old / nloc;
        if (old + 1u == (gen + 1u) * nloc) {
            __builtin_amdgcn_fence(__ATOMIC_RELEASE, "agent");
            asm volatile("s_waitcnt vmcnt(0)" ::: "memory");
            const unsigned og = xb_add(&bar[XB_TOP], 1u);
            const unsigned tg = og / nx;
            if (og + 1u == (tg + 1u) * nx) xb_add(&bar[XB_TOPGEN], 1u);
            else XB_SPIN(xb_ld(&bar[XB_TOPGEN]) == tg, bar);
            __builtin_amdgcn_fence(__ATOMIC_ACQUIRE, "agent");
            xb_add(&bar[XB_XGEN(b.x)], 1u);
            asm volatile("s_waitcnt vmcnt(0)" ::: "memory");
        } else {
            XB_SPIN(xb_ld(&bar[XB_XGEN(b.x)]) == gen, bar);
            __builtin_amdgcn_fence(__ATOMIC_ACQUIRE, "agent");
            asm volatile("s_waitcnt vmcnt(0)" ::: "memory");
        }
    }
    __syncthreads();
}

struct Args { const float* in[19]; float* out; unsigned char* ws; int ph_lo, ph_hi; };

struct MixP {
    const bf16_t* P;
    bf16_t* YS;
    int L;
    const float *conv_a, *ln_v_g, *ln_v_b, *b_s, *pool_scale, *conv_d, *conv_d_b, *ln_d_g, *ln_d_b;
    const bf16_t *WsB, *WpoolT, *WpwT;
};

__device__ __forceinline__ void mix_unit(const MixP& mp, LAS unsigned char* lds, int r0, int tid, int lane, int wave) {
    const bf16_t* P = mp.P; const int L = mp.L;
    const int fr = lane & 15, fq = lane >> 4;
    LAS float* HH = (LAS float*)lds;
    LAS bf16_t* AM = (LAS bf16_t*)(lds + R1_OFF);
    LAS float* CV = (LAS float*)(lds + R1_OFF);
    LAS bf16_t* AMD = (LAS bf16_t*)lds;
    LAS bf16_t* VN = (LAS bf16_t*)(lds + VN_OFF);
    const int seq0 = r0 & ~(L - 1);
#pragma unroll 1
    for (int it0 = tid; it0 < 64 * 32; it0 += 2 * NTHR) {
        u32x4 ld[2][8];
#pragma unroll
        for (int q = 0; q < 2; ++q) { const int it = it0 + q * NTHR, tok = it >> 5, oc = it & 31, r = r0 + tok, pos = r - seq0;
            const bf16_t* rp = P + (size_t)r * NC + oc * 8;
            const int dm = pos > 0 ? -NC : 0, dp = pos < L - 1 ? NC : 0;
            ld[q][0] = *(const u32x4*)(rp); ld[q][1] = *(const u32x4*)(rp + 256); ld[q][2] = *(const u32x4*)(rp + 512); ld[q][3] = *(const u32x4*)(rp + 768);
            ld[q][4] = *(const u32x4*)(rp + dm); ld[q][5] = *(const u32x4*)(rp + dm + 512); ld[q][6] = *(const u32x4*)(rp + dp); ld[q][7] = *(const u32x4*)(rp + dp + 512); }
#pragma unroll
        for (int q = 0; q < 2; ++q) { const int it = it0 + q * NTHR, tok = it >> 5, oc = it & 31, r = r0 + tok, pos = r - seq0;
            const float fm = pos > 0 ? 1.f : 0.f, fp = pos < L - 1 ? 1.f : 0.f;
            const float* wa = mp.conv_a + oc * 8;
            const f32x4 w0a = *(const f32x4*)(wa), w0b = *(const f32x4*)(wa + 4), w1a = *(const f32x4*)(wa + 256), w1b = *(const f32x4*)(wa + 260), w2a = *(const f32x4*)(wa + 512), w2b = *(const f32x4*)(wa + 516);
            const float w0[8] = {w0a[0] * fm, w0a[1] * fm, w0a[2] * fm, w0a[3] * fm, w0b[0] * fm, w0b[1] * fm, w0b[2] * fm, w0b[3] * fm};
            const float w1[8] = {w1a[0], w1a[1], w1a[2], w1a[3], w1b[0], w1b[1], w1b[2], w1b[3]};
            const float w2[8] = {w2a[0] * fp, w2a[1] * fp, w2a[2] * fp, w2a[3] * fp, w2b[0] * fp, w2b[1] * fp, w2b[2] * fp, w2b[3] * fp};
            UNPACK8(ld[q][0], h); UNPACK8(ld[q][1], bg); UNPACK8(ld[q][2], cgv); UNPACK8(ld[q][3], z); UNPACK8(ld[q][4], hmf); UNPACK8(ld[q][5], cmf); UNPACK8(ld[q][6], hpf); UNPACK8(ld[q][7], cpf);
            float y[8];
#pragma unroll
            for (int e = 0; e < 8; ++e) { const float cv = w0[e] * (cmf[e] * hmf[e]) + w1[e] * (cgv[e] * h[e]) + w2[e] * (cpf[e] * hpf[e]); y[e] = bg[e] * cv * silu(z[e]); }
            u32x4 o; o.x = pk2(y[0], y[1]); o.y = pk2(y[2], y[3]); o.z = pk2(y[4], y[5]); o.w = pk2(y[6], y[7]);
            *(u32x4*)(mp.YS + (size_t)r * D + oc * 8) = o; }
    }
    {
        const int tok = tid >> 3, o8 = tid & 7, r = r0 + tok, pos = r - seq0;
        const bf16_t* cb = P + (size_t)seq0 * NC + 7 * 256 + o8 * 8;
#define POOL_OUT(GI, WV, BASE, CT) do { const int half_ = 1 << (GI), lo_ = max(pos - half_, 0), hi_ = min(pos + half_, L), cnt_ = hi_ - lo_; \
            float s_[8] = {0.f, 0.f, 0.f, 0.f, 0.f, 0.f, 0.f, 0.f}; \
            _Pragma("unroll") for (int jj = 0; jj < 2 * half_; ++jj) { const float m_ = jj < cnt_ ? 1.f : 0.f; UNPACK8(WV[(BASE) + jj], f_); _Pragma("unroll") for (int e = 0; e < 8; ++e) s_[e] += m_ * f_[e]; } \
            UNPACK8(CT, c_); const float inv_ = 1.0f / (float)cnt_; \
            u32x4 o_; o_.x = pk2(s_[0] * inv_ - c_[0], s_[1] * inv_ - c_[1]); o_.y = pk2(s_[2] * inv_ - c_[2], s_[3] * inv_ - c_[3]); o_.z = pk2(s_[4] * inv_ - c_[4], s_[5] * inv_ - c_[5]); o_.w = pk2(s_[6] * inv_ - c_[6], s_[7] * inv_ - c_[7]); \
            *(LAS u32x4*)(AM + tok * AROW + (GI) * 64 + o8 * 8) = o_; } while (0)
#define POOL_LOAD(GI, WV, BASE, CT) do { const int half_ = 1 << (GI), lo_ = max(pos - half_, 0), hi_ = min(pos + half_, L); \
            _Pragma("unroll") for (int jj = 0; jj < 2 * half_; ++jj) WV[(BASE) + jj] = *(const u32x4*)(cb + (GI) * 64 + (size_t)min(lo_ + jj, hi_ - 1) * NC); \
            CT = *(const u32x4*)(cb + (GI) * 64 + (size_t)pos * NC); } while (0)
        {
            u32x4 wa[14], c0, c1, c2;
            POOL_LOAD(0, wa, 0, c0); POOL_LOAD(1, wa, 2, c1); POOL_LOAD(2, wa, 6, c2);
            POOL_OUT(0, wa, 0, c0); POOL_OUT(1, wa, 2, c1); POOL_OUT(2, wa, 6, c2);
        }
        {
            u32x4 wb[16], c3;
            POOL_LOAD(3, wb, 0, c3);
            POOL_OUT(3, wb, 0, c3);
        }
#undef POOL_OUT
#undef POOL_LOAD
    }
#pragma unroll 1
    for (int it0 = tid; it0 < 94 * 32; it0 += 3 * NTHR) {
        u32x4 la[3], lg[3];
#pragma unroll
        for (int q = 0; q < 3; ++q) { const int it = it0 + q * NTHR, j = it >> 5, oc = it & 31, r = r0 - 15 + j; const bool ok = it < 94 * 32 && r >= seq0 && r < seq0 + L;
            const bf16_t* rp = P + (size_t)(ok ? r : r0) * NC + 9 * 256 + oc * 8;
            la[q] = *(const u32x4*)(rp); lg[q] = *(const u32x4*)(rp + 256); }
#pragma unroll
        for (int q = 0; q < 3; ++q) { const int it = it0 + q * NTHR, j = it >> 5, oc = it & 31, r = r0 - 15 + j; const bool ok = r >= seq0 && r < seq0 + L;
            if (it < 94 * 32) {
                const float mk = ok ? 1.f : 0.f; UNPACK8(la[q], a); UNPACK8(lg[q], gg);
                const f32x4 o0 = (f32x4){mk * a[0] * sigm(gg[0]), mk * a[1] * sigm(gg[1]), mk * a[2] * sigm(gg[2]), mk * a[3] * sigm(gg[3])};
                const f32x4 o1 = (f32x4){mk * a[4] * sigm(gg[4]), mk * a[5] * sigm(gg[5]), mk * a[6] * sigm(gg[6]), mk * a[7] * sigm(gg[7])};
                *(LAS f32x4*)(HH + j * 256 + oc * 8) = o0; *(LAS f32x4*)(HH + j * 256 + oc * 8 + 4) = o1; } }
    }
    __syncthreads();
    {
        const int gi = wave >> 1;
        f32x4 acc[4][2];
#pragma unroll
        for (int rb = 0; rb < 4; ++rb) { acc[rb][0] = (f32x4){0.f, 0.f, 0.f, 0.f}; acc[rb][1] = acc[rb][0]; }
#pragma unroll
        for (int ks = 0; ks < 2; ++ks) {
            bf16x8 bfr[2], afr[4];
#pragma unroll
            for (int cj = 0; cj < 2; ++cj) bfr[cj] = *(const bf16x8*)(mp.WpoolT + (size_t)(gi * 64 + ((32 * wave + 16 * cj) & 63) + fr) * 64 + ks * 32 + fq * 8);
#pragma unroll
            for (int rb = 0; rb < 4; ++rb) afr[rb] = *(const LAS bf16x8*)(AM + (rb * 16 + fr) * AROW + gi * 64 + ks * 32 + fq * 8);
#pragma unroll
            for (int rb = 0; rb < 4; ++rb)
#pragma unroll
                for (int cj = 0; cj < 2; ++cj) acc[rb][cj] = MFMA16(bfr[cj], afr[rb], acc[rb][cj]);
        }
#pragma unroll
        for (int rb = 0; rb < 4; ++rb)
#pragma unroll
            for (int cj = 0; cj < 2; ++cj) { const int r = r0 + rb * 16 + fr, col = 32 * wave + 16 * cj + 4 * fq;
                const u32x2 vz = *(const u32x2*)(P + (size_t)r * NC + 8 * 256 + col); const f32x4 sc = *(const f32x4*)(mp.pool_scale + col);
                const float z0 = bflo(vz.x), z1 = bfhi(vz.x), z2 = bflo(vz.y), z3 = bfhi(vz.y);
                u32x2 o; o.x = pk2(acc[rb][cj][0] * sc[0] * silu(z0), acc[rb][cj][1] * sc[1] * silu(z1)); o.y = pk2(acc[rb][cj][2] * sc[2] * silu(z2), acc[rb][cj][3] * sc[3] * silu(z3));
                *(u32x2*)(mp.YS + (size_t)r * D + 512 + col) = o; }
    }
    __syncthreads();
    {
        const int c = tid & 255, hf = tid >> 8;
        f32x2 w2[16];
#pragma unroll
        for (int j = 0; j < 15; ++j) w2[j] = (f32x2){mp.conv_d[(2 * j) * 256 + c], mp.conv_d[(2 * j + 1) * 256 + c]};
        w2[15] = (f32x2){mp.conv_d[30 * 256 + c], 0.f};
        const float bias = mp.conv_d_b[c];
#pragma unroll 1
        for (int g4 = 0; g4 < 4; ++g4) {
            const LAS float* hp = HH + (hf * 32 + g4 * 8) * 256 + c;
            f32x2 E[19], O[19];
#pragma unroll
            for (int i = 0; i < 19; ++i) { E[i] = (f32x2){hp[(2 * i) * 256], hp[(2 * i + 1) * 256]}; O[i] = (f32x2){hp[(2 * i + 1) * 256], i < 18 ? hp[(2 * i + 2) * 256] : 0.f}; }
#pragma unroll
            for (int o = 0; o < 8; ++o) { f32x2 a2 = (f32x2){bias, 0.f};
#pragma unroll
                for (int j = 0; j < 16; ++j) a2 = __builtin_elementwise_fma(w2[j], (o & 1) ? O[(o + 2 * j - 1) / 2] : E[(o + 2 * j) / 2], a2);
                CV[(hf * 32 + g4 * 8 + o) * 256 + c] = a2[0] + a2[1]; }
            asm volatile("" ::: "memory");
        }
    }
    __syncthreads();
    {
        const int t4 = lane >> 4, pp = lane & 15;
        f32x4 gv[4], bv[4];
#pragma unroll
        for (int j = 0; j < 4; ++j) { gv[j] = *(const f32x4*)(mp.ln_d_g + 4 * pp + 64 * j); bv[j] = *(const f32x4*)(mp.ln_d_b + 4 * pp + 64 * j); }
#pragma unroll
        for (int it = 0; it < 2; ++it) { const int tok = wave * 8 + it * 4 + t4;
            f32x4 v[4]; float sm = 0.f;
#pragma unroll
            for (int j = 0; j < 4; ++j) { v[j] = *(const LAS f32x4*)(CV + tok * 256 + 4 * pp + 64 * j); sm += (v[j][0] + v[j][1]) + (v[j][2] + v[j][3]); }
            const float mean = red16(sm) * (1.f / 256.f); float sq = 0.f;
#pragma unroll
            for (int j = 0; j < 4; ++j) { v[j] = v[j] - mean; sq += (v[j][0] * v[j][0] + v[j][1] * v[j][1]) + (v[j][2] * v[j][2] + v[j][3] * v[j][3]); }
            const float rstd = 1.0f / sqrtf(red16(sq) * (1.f / 256.f) + LN_EPS);
#pragma unroll
            for (int j = 0; j < 4; ++j) { const f32x4 y = v[j] * rstd * gv[j] + bv[j];
                u32x2 o; o.x = pk2(silu(y[0]), silu(y[1])); o.y = pk2(silu(y[2]), silu(y[3]));
                *(LAS u32x2*)(AMD + tok * AROW + 4 * pp + 64 * j) = o; } }
    }
    __syncthreads();
    {
        f32x4 acc[4][2];
#pragma unroll
        for (int rb = 0; rb < 4; ++rb) { acc[rb][0] = (f32x4){0.f, 0.f, 0.f, 0.f}; acc[rb][1] = acc[rb][0]; }
#pragma unroll
        for (int ks = 0; ks < 8; ++ks) {
            bf16x8 bfr[2], afr[4];
#pragma unroll
            for (int cj = 0; cj < 2; ++cj) bfr[cj] = *(const bf16x8*)(mp.WpwT + (size_t)(32 * wave + 16 * cj + fr) * 256 + ks * 32 + fq * 8);
#pragma unroll
            for (int rb = 0; rb < 4; ++rb) afr[rb] = *(const LAS bf16x8*)(AMD + (rb * 16 + fr) * AROW + ks * 32 + fq * 8);
#pragma unroll
            for (int rb = 0; rb < 4; ++rb)
#pragma unroll
                for (int cj = 0; cj < 2; ++cj) acc[rb][cj] = MFMA16(bfr[cj], afr[rb], acc[rb][cj]);
        }
#pragma unroll
        for (int rb = 0; rb < 4; ++rb)
#pragma unroll
            for (int cj = 0; cj < 2; ++cj) { const int r = r0 + rb * 16 + fr, col = 32 * wave + 16 * cj + 4 * fq;
                const u32x2 vz = *(const u32x2*)(P + (size_t)r * NC + 11 * 256 + col);
                const float z0 = bflo(vz.x), z1 = bfhi(vz.x), z2 = bflo(vz.y), z3 = bfhi(vz.y);
                u32x2 o; o.x = pk2(acc[rb][cj][0] * silu(z0), acc[rb][cj][1] * silu(z1)); o.y = pk2(acc[rb][cj][2] * silu(z2), acc[rb][cj][3] * silu(z3));
                *(u32x2*)(mp.YS + (size_t)r * D + 768 + col) = o; }
    }
    const int rc = r0 & ~127, p0 = r0 & 127;
    {
        const int t4 = lane >> 4, pp = lane & 15;
        u32x2 vpre[4][4];
#pragma unroll
        for (int it = 0; it < 4; ++it)
#pragma unroll
            for (int j = 0; j < 4; ++j) vpre[it][j] = *(const u32x2*)(P + (size_t)(rc + wave * 16 + it * 4 + t4) * NC + 5 * 256 + 4 * pp + 64 * j);
        f32x4 gv[4], bv[4];
#pragma unroll
        for (int j = 0; j < 4; ++j) { gv[j] = *(const f32x4*)(mp.ln_v_g + 4 * pp + 64 * j); bv[j] = *(const f32x4*)(mp.ln_v_b + 4 * pp + 64 * j); }
#pragma unroll
        for (int it = 0; it < 4; ++it) { const int q = wave * 16 + it * 4 + t4;
            f32x4 v[4]; float sm = 0.f;
#pragma unroll
            for (int j = 0; j < 4; ++j) { const u32x2 vv = vpre[it][j]; v[j] = (f32x4){bflo(vv.x), bfhi(vv.x), bflo(vv.y), bfhi(vv.y)}; sm += (v[j][0] + v[j][1]) + (v[j][2] + v[j][3]); }
            const float mean = red16(sm) * (1.f / 256.f); float sq = 0.f;
#pragma unroll
            for (int j = 0; j < 4; ++j) { v[j] = v[j] - mean; sq += (v[j][0] * v[j][0] + v[j][1] * v[j][1]) + (v[j][2] * v[j][2] + v[j][3] * v[j][3]); }
            const float rstd = 1.0f / sqrtf(red16(sq) * (1.f / 256.f) + LN_EPS);
#pragma unroll
            for (int j = 0; j < 4; ++j) { const f32x4 y = v[j] * rstd * gv[j] + bv[j];
                u32x2 o; o.x = pk2(y[0], y[1]); o.y = pk2(y[2], y[3]);
                *(LAS u32x2*)(VN + q * VROW + 4 * pp + 64 * j) = o; } }
    }
    __syncthreads();
    {
        const int h = wave >> 1;
        f32x4 acc[4][2];
#pragma unroll
        for (int rb = 0; rb < 4; ++rb) { acc[rb][0] = (f32x4){0.f, 0.f, 0.f, 0.f}; acc[rb][1] = acc[rb][0]; }
#pragma unroll
        for (int ks = 0; ks < 4; ++ks) {
            bf16x8 xfr[2], yfr[4];
#pragma unroll
            for (int cj = 0; cj < 2; ++cj) { const LAS bf16_t* vp = VN + (ks * 32 + fq * 8) * VROW + 32 * wave + 16 * cj + fr;
#pragma unroll
                for (int jj = 0; jj < 8; ++jj) xfr[cj][jj] = (short)vp[jj * VROW]; }
#pragma unroll
            for (int rb = 0; rb < 4; ++rb) yfr[rb] = *(const bf16x8*)(mp.WsB + (size_t)(h * 128 + p0 + rb * 16 + fr) * 128 + ks * 32 + fq * 8);
#pragma unroll
            for (int rb = 0; rb < 4; ++rb)
#pragma unroll
                for (int cj = 0; cj < 2; ++cj) acc[rb][cj] = MFMA16(xfr[cj], yfr[rb], acc[rb][cj]);
        }
#pragma unroll
        for (int rb = 0; rb < 4; ++rb) { const int p = p0 + rb * 16 + fr, r = rc + p; const float bias = mp.b_s[h * 128 + p];
#pragma unroll
            for (int cj = 0; cj < 2; ++cj) { const int col = 32 * wave + 16 * cj + 4 * fq;
                const u32x2 vu = *(const u32x2*)(P + (size_t)r * NC + 4 * 256 + col), vz = *(const u32x2*)(P + (size_t)r * NC + 6 * 256 + col);
                const float u0 = bflo(vu.x), u1 = bfhi(vu.x), u2 = bflo(vu.y), u3 = bfhi(vu.y), z0 = bflo(vz.x), z1 = bfhi(vz.x), z2 = bflo(vz.y), z3 = bfhi(vz.y);
                u32x2 o; o.x = pk2(u0 * (acc[rb][cj][0] + bias) * silu(z0), u1 * (acc[rb][cj][1] + bias) * silu(z1));
                o.y = pk2(u2 * (acc[rb][cj][2] + bias) * silu(z2), u3 * (acc[rb][cj][3] + bias) * silu(z3));
                *(u32x2*)(mp.YS + (size_t)r * D + 256 + col) = o; } }
    }
    __syncthreads();
}

__device__ __forceinline__ void final_ln(float* out, const float* stats, const float* lg, const float* lb, int vcu, int G, int tid) {
    const size_t n4 = (size_t)TS * 256, gt = (size_t)vcu * NTHR + tid, NGT = (size_t)G * NTHR;
    f32x4* o4 = (f32x4*)out;
#pragma unroll 1
    for (size_t i0 = gt; i0 < n4; i0 += 8 * NGT) {
        f32x4 v[8];
#pragma unroll
        for (int q = 0; q < 8; ++q) { const size_t i = i0 + q * NGT; v[q] = o4[i < n4 ? i : i0]; }
#pragma unroll
        for (int q = 0; q < 8; ++q) { const size_t i = i0 + q * NGT;
            if (i < n4) { const size_t row = i >> 8; const int c4 = (int)(i & 255);
                const float sm = stats[2 * row], sq = stats[2 * row + 1];
                const float mu = sm * (1.f / 1024.f), rstd = 1.0f / sqrtf(fmaxf(sq * (1.f / 1024.f) - mu * mu, 0.f) + LN_EPS);
                o4[i] = (v[q] - mu) * rstd * ((const f32x4*)lg)[c4] + ((const f32x4*)lb)[c4]; } }
    }
}

__global__ void __launch_bounds__(NTHR, 2) fwd_megakernel(Args args_unused) {
    extern __shared__ __attribute__((aligned(16))) unsigned char lds_raw[];
    LAS unsigned char* lds = (LAS unsigned char*)lds_raw;
    cg::grid_group grid = cg::this_grid();
    const int G = gridDim.x, bx = blockIdx.x;
    const int vcu = (G % 8 == 0) ? (bx % 8) * (G / 8) + bx / 8 : bx;
    typedef const __attribute__((address_space(4))) Args* KArgs;
#define PH_TID int tid = threadIdx.x; asm volatile("" : "+v"(tid)); const int lane = tid & 63, wave = __builtin_amdgcn_readfirstlane(tid >> 6); (void)lane; (void)wave; \
    KArgs ka = (KArgs)__builtin_amdgcn_kernarg_segment_ptr(); asm volatile("" : "+s"(ka)); \
    unsigned char* ws = ka->ws; \
    bf16_t* WinT = (bf16_t*)(ws + WS_WIN); bf16_t* WbrT = (bf16_t*)(ws + WS_WBR); bf16_t* WoutT = (bf16_t*)(ws + WS_WOUT); \
    bf16_t* WpwT = (bf16_t*)(ws + WS_WPW); bf16_t* WpoolT = (bf16_t*)(ws + WS_WPOOL); bf16_t* WsB = (bf16_t*)(ws + WS_WS); \
    bf16_t* XB = (bf16_t*)(ws + WS_XB); bf16_t* XB1 = (bf16_t*)(ws + WS_XB1); bf16_t* PROJ = (bf16_t*)(ws + WS_PROJ); \
    bf16_t* YS = (bf16_t*)(ws + WS_YS); bf16_t* MRG = (bf16_t*)(ws + WS_MRG); float* PRE = (float*)(ws + WS_PRE); \
    float* CS = (float*)(ws + WS_CSBW); float* BW = CS + NC; float* STATS = (float*)(ws + WS_STATS); \
    (void)WinT; (void)WbrT; (void)WoutT; (void)WpwT; (void)WpoolT; (void)WsB; (void)XB; (void)XB1; (void)PROJ; (void)YS; (void)MRG; (void)PRE; (void)CS; (void)BW; (void)STATS
#define SB_VARS const size_t row0 = (size_t)sb * TS; const bool prompt = row0 < (size_t)NPROMPT; \
    const float* xin = prompt ? ka->in[0] + row0 * D : ka->in[1] + (row0 - NPROMPT) * D; float* outp = ka->out + row0 * D; const int L = prompt ? 4096 : 16384; \
    float* st0 = STATS + 2 * row0; float* st1 = STATS + 2 * (size_t)TALL + 2 * row0; (void)xin; (void)outp; (void)L; (void)st0; (void)st1
    const int lo = args_unused.ph_lo, hi = args_unused.ph_hi;
    int ph = 0;
    if (threadIdx.x < 16) ((LAS unsigned*)(lds + XB_LDS_OFF))[threadIdx.x] = 0u;
    __syncthreads();
    const XcdBarrier xbar = xcd_barrier_post((unsigned*)args_unused.ws, (volatile LAS unsigned*)(lds + XB_LDS_OFF));
#define PH_IN (ph >= lo && ph < hi)
#define PH_END do { ++ph; if (ph > lo && ph < hi) { if (hi < 0) grid.sync(); else { for (int rb_ = 0; rb_ < REP_BAR; ++rb_) xcd_barrier(xbar); } } } while (0)

    if (PH_IN) {
        PH_TID;
        LAS float* scr = (LAS float*)(lds + wave * 16384);
        const int gw = vcu * NWAVES + wave, NGW = G * NWAVES;
        constexpr int I_IN = (D / 64) * (NC / 32), I_SQ = (D / 64) * (D / 32), I_PW = (256 / 64) * (256 / 32), I_PL = 2;
        constexpr int PER_L = I_IN + 2 * I_SQ + I_PW + 4 * I_PL, NITEMS = DEPTH * PER_L;
        for (int it = gw; it < NITEMS; it += NGW) {
            const int l = it / PER_L; int r = it % PER_L;
            if (r < I_IN) { transpose_item(ka->in[2] + (size_t)l * D * NC, D, NC, WinT + (size_t)l * NC * D, scr, r, lane, l == 1 ? ka->in[17] : nullptr, ka->in[18], CS, BW, true); continue; } r -= I_IN;
            if (r < I_SQ) { transpose_item(ka->in[15] + (size_t)l * D * D, D, D, WbrT + (size_t)l * D * D, scr, r, lane, nullptr, nullptr, nullptr, nullptr, false); continue; } r -= I_SQ;
            if (r < I_SQ) { transpose_item(ka->in[16] + (size_t)l * D * D, D, D, WoutT + (size_t)l * D * D, scr, r, lane, nullptr, nullptr, nullptr, nullptr, false); continue; } r -= I_SQ;
            if (r < I_PW) { transpose_item(ka->in[14] + (size_t)l * 65536, 256, 256, WpwT + (size_t)l * 65536, scr, r, lane, nullptr, nullptr, nullptr, nullptr, false); continue; } r -= I_PW;
            { const int gi = r / I_PL; transpose_item(ka->in[8] + (size_t)(l * 4 + gi) * 4096, 64, 64, WpoolT + (size_t)(l * 4 + gi) * 4096, scr, r % I_PL, lane, nullptr, nullptr, nullptr, nullptr, false); }
        }
        const size_t gt = (size_t)vcu * NTHR + tid, NGT = (size_t)G * NTHR;
        for (size_t i = gt; i < (size_t)2 * TALL * 2 / 4; i += NGT) ((f32x4*)STATS)[i] = (f32x4){0.f, 0.f, 0.f, 0.f};
        for (size_t i = gt; i < (size_t)DEPTH * 4 * 128 * 128 / 4; i += NGT) { const f32x4 v = *(const f32x4*)(ka->in[6] + 4 * i); u32x2 o; o.x = pk2(v[0], v[1]); o.y = pk2(v[2], v[3]); *(u32x2*)(WsB + 4 * i) = o; }
        for (size_t i0 = gt; i0 < (size_t)TALL * D / 8; i0 += 8 * NGT) {
            f32x4 a[8], b[8];
#pragma unroll
            for (int q = 0; q < 8; ++q) { const size_t i = i0 + q * NGT, e = 8 * (i < (size_t)TALL * D / 8 ? i : i0);
                const float* src = e < (size_t)NPROMPT * D ? ka->in[0] + e : ka->in[1] + (e - (size_t)NPROMPT * D);
                a[q] = *(const f32x4*)(src); b[q] = *(const f32x4*)(src + 4); }
#pragma unroll
            for (int q = 0; q < 8; ++q) { const size_t i = i0 + q * NGT;
                if (i < (size_t)TALL * D / 8) { u32x4 o; o.x = pk2(a[q][0], a[q][1]); o.y = pk2(a[q][2], a[q][3]); o.z = pk2(b[q][0], b[q][1]); o.w = pk2(b[q][2], b[q][3]);
                    *(u32x4*)(XB + 8 * i) = o; } }
        }
        __syncthreads();
    }
    PH_END;

    for (int sb = 0; sb < NSB; ++sb) {
        for (int l = 0; l < DEPTH; ++l) {
            for (int hf = 0; hf < 2; ++hf) {
                if (PH_IN) {
                    if (hf == 1) {
                        PH_TID; SB_VARS;
                        if (l == 0 && sb > 0) final_ln(outp - (size_t)TS * D, st1 - 2 * (size_t)TS, ka->in[17] + D, ka->in[18] + D, vcu, G, tid);
                        MixP mp;
                        mp.P = PROJ; mp.YS = YS; mp.L = L;
                        mp.conv_a = ka->in[3] + l * 3 * 256; mp.ln_v_g = ka->in[4] + l * 256; mp.ln_v_b = ka->in[5] + l * 256; mp.b_s = ka->in[7] + l * 512;
                        mp.pool_scale = ka->in[9] + l * 256; mp.conv_d = ka->in[10] + l * 31 * 256; mp.conv_d_b = ka->in[11] + l * 256; mp.ln_d_g = ka->in[12] + l * 256; mp.ln_d_b = ka->in[13] + l * 256;
                        mp.WsB = WsB + (size_t)l * 65536; mp.WpoolT = WpoolT + (size_t)l * 16384; mp.WpwT = WpwT + (size_t)l * 65536;
                        for (int rep = 0; rep < REP_MIX; ++rep) for (int u = vcu; u < TS / 64; u += G) mix_unit(mp, lds, u * 64, tid, lane, wave);
                    }
                    PH_TID; SB_VARS;
                    const int cofs = hf == 0 ? 0 : NBRC, ncol = hf == 0 ? NBRC : NC - NBRC;
                    pg8::Gemm g{l == 0 ? XB + row0 * D : XB1, WinT + (size_t)l * NC * D + (size_t)cofs * D};
                    pg8::StaticOrder S; S.init(TS, ncol, G, bx);
                    pg8::RepOrder<pg8::StaticOrder, REP_G1> R; R.S = S; R.n = (S.nwg - bx + G - 1) / G;
#define G1_CALL(FOLD_, SIG_, ST_) do { pg8::EpiStoreBf16<FOLD_, SIG_> E{PROJ + cofs, NC, ST_, CS + cofs, BW + cofs}; \
                        pg8::gemm_phase<pg8::EpiStoreBf16<FOLD_, SIG_>, pg8::RepOrder<pg8::StaticOrder, REP_G1>, true, 1024>(lds, g, R, E, tid); } while (0)
                    if (l == 0) { if (hf == 0) G1_CALL(false, false, nullptr); else G1_CALL(false, true, nullptr); }
                    else { if (hf == 0) G1_CALL(true, false, st0); else G1_CALL(true, true, st0); }
#undef G1_CALL
                }
                PH_END;
            }
            if (PH_IN) {
                PH_TID; SB_VARS;
                pg8::Gemm g{YS, WbrT + (size_t)l * D * D};
                pg8::SubOrder<4> S; S.S.init(TS, D, G, bx);
                pg8::EpiGate E{PROJ + 3072, NC, MRG, D};
                pg8::RepOrder<pg8::SubOrder<4>, REP_BR> R; R.S = S; R.n = 4 * ((S.S.nwg - bx + G - 1) / G);
                pg8::gemm_phase<pg8::EpiGate, pg8::RepOrder<pg8::SubOrder<4>, REP_BR>, true, 256>(lds, g, R, E, tid);
            }
            PH_END;
            if (PH_IN) {
                PH_TID; SB_VARS;
                pg8::Gemm g{MRG, WoutT + (size_t)l * D * D};
                pg8::StaticOrder S; S.init(TS, D, G, bx);
                pg8::RepOrder<pg8::StaticOrder, REP_OUT> R; R.S = S; R.n = (S.nwg - bx + G - 1) / G;
                if (l == 0) { pg8::EpiRes<false> E{xin, nullptr, nullptr, nullptr, PRE, XB1, st0, D, ALPHA};
                    pg8::gemm_phase<pg8::EpiRes<false>, pg8::RepOrder<pg8::StaticOrder, REP_OUT>, true, 1024>(lds, g, R, E, tid); }
                else { pg8::EpiRes<true> E{PRE, st0, ka->in[17], ka->in[18], outp, nullptr, st1, D, ALPHA};
                    pg8::gemm_phase<pg8::EpiRes<true>, pg8::RepOrder<pg8::StaticOrder, REP_OUT>, true, 1024>(lds, g, R, E, tid); }
            }
            if (!(l == DEPTH - 1 && sb + 1 < NSB)) PH_END;
        }
    }
    if (PH_IN) {
        PH_TID;
        final_ln(ka->out + (size_t)(NSB - 1) * TS * D, STATS + 2 * (size_t)TALL + 2 * (size_t)(NSB - 1) * TS, ka->in[17] + D, ka->in[18] + D, vcu, G, tid);
    }
#undef PH_IN
#undef PH_END
}

extern "C" void kernel_launch(void* const* d_in, const int* in_sizes, int n_in, void* d_out, int out_size, void* d_ws, size_t ws_size, hipStream_t stream) {
    static int grid = 0;
    if (grid == 0) {
        if (n_in != 19 || ws_size < WS_END || out_size != TALL * D) { fprintf(stderr, "kernel_launch: unexpected shapes (n_in %d, out %d, ws %zu)\n", n_in, out_size, ws_size); grid = -1; return; }
        int dev = 0, cus = 0, per_cu = 0;
        if (hipGetDevice(&dev) != hipSuccess || hipDeviceGetAttribute(&cus, hipDeviceAttributeMultiprocessorCount, dev) != hipSuccess) { grid = -1; return; }
        if (hipFuncSetAttribute((const void*)fwd_megakernel, hipFuncAttributeMaxDynamicSharedMemorySize, LDS_BYTES) != hipSuccess) { fprintf(stderr, "kernel_launch: hipFuncSetAttribute failed\n"); grid = -1; return; }
        if (hipOccupancyMaxActiveBlocksPerMultiprocessor(&per_cu, (const void*)fwd_megakernel, NTHR, LDS_BYTES) != hipSuccess || per_cu < 1) { fprintf(stderr, "kernel_launch: occupancy query says %d\n", per_cu); per_cu = 1; }
        (void)hipGetLastError();
        grid = cus * per_cu;
    }
    if (grid < 0) return;
    if (hipMemsetAsync(d_ws, 0, CTL_ZERO_BYTES, stream) != hipSuccess) { fprintf(stderr, "kernel_launch: memset failed\n"); return; }
    Args a{};
    for (int i = 0; i < 19; ++i) a.in[i] = (const float*)d_in[i];
    a.out = (float*)d_out; a.ws = (unsigned char*)d_ws; a.ph_lo = 0; a.ph_hi = 1 << 20;
    void* kargs[] = {&a};
    hipError_t e = hipLaunchCooperativeKernel((const void*)fwd_megakernel, dim3(grid), dim3(NTHR), kargs, LDS_BYTES, stream);
    if (e != hipSuccess) fprintf(stderr, "kernel_launch: cooperative launch failed: %s (grid %d)\n", hipGetErrorString(e), grid);
}
```
